# Optimizing an MI355X kernel written in HIP

```python
import math
import jax, jax.numpy as jnp
from jax import lax
import numpy as np

D_MODEL = 1024
BATCH = 32
SEQ = 2048
DEPTH = 1

MIX_W = D_MODEL
POOL_W = (3 * D_MODEL) // 8
SSM_W = (3 * D_MODEL) // 8
ATT_W = D_MODEL - POOL_W - SSM_W
IN_W = 2 * MIX_W
POOL_WINDOWS = (2, 4, 8, 16)
POOL_GROUPS = len(POOL_WINDOWS)
POOL_GW = POOL_W // POOL_GROUPS
SSM_GROUP = 16
SSM_NG = SSM_W // SSM_GROUP
SSM_N = 64
DT_MIN = 1e-3
DT_MAX = 1e-1
N_MEM = 256
MEM_HEADS = 4
MEM_HD = ATT_W // MEM_HEADS
EPS = 1e-6

kernel_name = "hybrid_pool_s5_memattn_layer"


def rmsnorm(x, g):
    xf = x.astype(jnp.float32)
    xf = xf * lax.rsqrt(jnp.mean(xf * xf, axis=-1, keepdims=True) + EPS)
    return (xf * g.astype(jnp.float32)).astype(x.dtype)


def pool_mixer(u, w_pool, pool_scale):
    b, l, _ = u.shape
    uf = u.astype(jnp.float32)
    cs0 = jnp.concatenate([jnp.zeros((b, 1, POOL_W), jnp.float32), jnp.cumsum(uf, axis=1)], axis=1)
    pos = jnp.arange(1, l + 1, dtype=jnp.float32)[None, :, None]
    outs = []
    for gi, w in enumerate(POOL_WINDOWS):
        sl = slice(gi * POOL_GW, (gi + 1) * POOL_GW)
        c = cs0[..., sl]
        lower = jnp.concatenate([jnp.zeros((b, w - 1, POOL_GW), jnp.float32), c[:, :l - w + 1]], axis=1)
        mean = (c[:, 1:] - lower) / jnp.minimum(pos, float(w))
        outs.append(jnp.einsum('blc,cd->bld', mean - uf[..., sl], w_pool[gi].astype(jnp.float32)))
    y = jnp.concatenate(outs, axis=-1) * pool_scale.astype(jnp.float32)
    return y.astype(u.dtype)


def _ssm_combine(e1, e2):
    a1, b1 = e1
    a2, b2 = e2
    return a1 * a2, a2 * b1 + b2


def s5_mixer(u, a_re, a_im, log_dt, b_re, b_im, c_re, c_im, d_skip, w_glu):
    bsz, l, _ = u.shape
    f32 = jnp.float32
    uf = u.astype(f32).reshape(bsz, l, SSM_NG, SSM_GROUP)
    lam = lax.complex(a_re.astype(f32), a_im.astype(f32))
    dt = jnp.exp(log_dt.astype(f32))[:, None]
    lam_bar = jnp.exp(lam * dt)
    b_mat = lax.complex(b_re.astype(f32), b_im.astype(f32))
    c_mat = lax.complex(c_re.astype(f32), c_im.astype(f32))
    b_bar = ((lam_bar - 1.0) / lam)[..., None] * b_mat
    bu = jnp.einsum('blgc,gnc->blgn', uf.astype(jnp.complex64), b_bar)
    lam_all = jnp.broadcast_to(lam_bar, bu.shape)
    _, hs = lax.associative_scan(_ssm_combine, (lam_all, bu), axis=1)
    y = jnp.einsum('blgn,gcn->blgc', hs, c_mat).real + d_skip.astype(f32).reshape(SSM_NG, SSM_GROUP) * uf
    y = jax.nn.gelu(y.reshape(bsz, l, SSM_W))
    z = y @ w_glu.astype(f32)
    out = z[..., :SSM_W] * jax.nn.sigmoid(z[..., SSM_W:])
    return out.astype(u.dtype)


def memory_attention(q, mem, g_mem, w_kv):
    bsz, l, _ = q.shape
    m = rmsnorm(mem, g_mem)
    kv = m @ w_kv
    k = kv[..., :ATT_W].reshape(bsz, -1, MEM_HEADS, MEM_HD).astype(jnp.float32)
    v = kv[..., ATT_W:].reshape(bsz, -1, MEM_HEADS, MEM_HD).astype(jnp.float32)
    qh = q.reshape(bsz, l, MEM_HEADS, MEM_HD).astype(jnp.float32)
    s = jnp.einsum('blhd,bmhd->bhlm', qh, k) * (MEM_HD ** -0.5)
    p = jax.nn.softmax(s, axis=-1)
    o = jnp.einsum('bhlm,bmhd->blhd', p, v).reshape(bsz, l, ATT_W)
    return o.astype(q.dtype)


def setup_inputs(seed: int = 0) -> dict:
    key = jax.random.key(seed)
    ks = jax.random.split(key, 20)
    f32 = jnp.float32
    nrm = lambda k, shape, s: jax.random.normal(k, shape, f32) * s
    n_idx = jnp.arange(SSM_N, dtype=f32)
    a_re = -0.5 + nrm(ks[5], (DEPTH, SSM_NG, SSM_N), 1e-2)
    a_im = math.pi * n_idx[None, None, :] + nrm(ks[6], (DEPTH, SSM_NG, SSM_N), 1e-2)
    log_dt = jax.random.uniform(ks[7], (DEPTH, SSM_NG), f32, math.log(DT_MIN), math.log(DT_MAX))
    return {
        "x": nrm(ks[0], (BATCH, SEQ, D_MODEL), 1.0),
        "mem": nrm(ks[1], (BATCH, N_MEM, D_MODEL), 1.0),
        "g_pre": 1.0 + nrm(ks[2], (DEPTH, D_MODEL), 0.02),
        "w_in": nrm(ks[3], (DEPTH, D_MODEL, IN_W), D_MODEL ** -0.5),
        "w_pool": nrm(ks[4], (DEPTH, POOL_GROUPS, POOL_GW, POOL_GW), POOL_GW ** -0.5),
        "pool_scale": 1.0 + nrm(ks[8], (DEPTH, POOL_W), 0.02),
        "a_re": a_re,
        "a_im": a_im,
        "log_dt": log_dt,
        "b_re": nrm(ks[9], (DEPTH, SSM_NG, SSM_N, SSM_GROUP), (2 * SSM_GROUP) ** -0.5),
        "b_im": nrm(ks[10], (DEPTH, SSM_NG, SSM_N, SSM_GROUP), (2 * SSM_GROUP) ** -0.5),
        "c_re": nrm(ks[11], (DEPTH, SSM_NG, SSM_GROUP, SSM_N), (2 * SSM_N) ** -0.5),
        "c_im": nrm(ks[12], (DEPTH, SSM_NG, SSM_GROUP, SSM_N), (2 * SSM_N) ** -0.5),
        "d_skip": nrm(ks[13], (DEPTH, SSM_W), 1.0),
        "w_glu": nrm(ks[14], (DEPTH, SSM_W, 2 * SSM_W), SSM_W ** -0.5),
        "g_mem": 1.0 + nrm(ks[15], (DEPTH, D_MODEL), 0.02),
        "w_kv": nrm(ks[16], (DEPTH, D_MODEL, 2 * ATT_W), D_MODEL ** -0.5),
        "w_out": nrm(ks[17], (DEPTH, MIX_W, D_MODEL), MIX_W ** -0.5),
        "g_post": 1.0 + nrm(ks[18], (DEPTH, D_MODEL), 0.02),
    }


def reference(x, mem, g_pre, w_in, w_pool, pool_scale, a_re, a_im, log_dt, b_re, b_im,
              c_re, c_im, d_skip, w_glu, g_mem, w_kv, w_out, g_post):
    for i in range(DEPTH):
        h = rmsnorm(x, g_pre[i])
        proj = h @ w_in[i]
        val, gate = proj[..., :MIX_W], proj[..., MIX_W:]
        u_pool = val[..., :POOL_W]
        u_ssm = val[..., POOL_W:POOL_W + SSM_W]
        q = val[..., POOL_W + SSM_W:]
        y_pool = pool_mixer(u_pool, w_pool[i], pool_scale[i])
        y_ssm = s5_mixer(u_ssm, a_re[i], a_im[i], log_dt[i], b_re[i], b_im[i],
                         c_re[i], c_im[i], d_skip[i], w_glu[i])
        y_att = memory_attention(q, mem, g_mem[i], w_kv[i])
        y = jnp.concatenate([y_pool, y_ssm, y_att], axis=-1) * jax.nn.silu(gate)
        out = y @ w_out[i]
        x = x + rmsnorm(out, g_post[i])
    return x
```

```cpp
#include <hip/hip_runtime.h>
#include <hip/hip_cooperative_groups.h>
#include <cstdio>
#include <cstdint>
namespace cg = cooperative_groups;

#ifndef ONE_LAUNCH
#define ONE_LAUNCH 1
#endif

#define LAS __attribute__((address_space(3)))
typedef unsigned short bf16_t;
typedef short bf16x8 __attribute__((ext_vector_type(8)));
typedef float f32x4 __attribute__((ext_vector_type(4)));
typedef unsigned u32x4 __attribute__((ext_vector_type(4)));
typedef unsigned u32x2 __attribute__((ext_vector_type(2)));

constexpr int NB = 32, SEQ = 2048, DM = 1024, NTOK = NB * SEQ;
constexpr int POOLW = 384, SSMW = 384, ATTW = 256, INW = 2048;
constexpr int NG = 24, SN = 64, SG = 16;
constexpr int CT = 32, NCH = SEQ / CT, NRC = NB * NCH;
constexpr int UK = CT * SG;
constexpr int UROW = NG * 640;
constexpr int NMEM = 256, NH = 4, HD = 64;
constexpr float EPS = 1e-6f;

constexpr size_t MB_ = 1024 * 1024;
constexpr size_t WS_HB = 0;
constexpr size_t WS_PROJ = WS_HB + 128 * MB_;
constexpr size_t WS_UBUF = WS_PROJ + 256 * MB_;
constexpr size_t WS_SEND = WS_UBUF + (size_t)NRC * UROW * 2;
constexpr size_t WS_YBUF = WS_SEND + (size_t)NRC * 3072 * 4;
constexpr size_t WS_SSQ = WS_YBUF + (size_t)NTOK * 384 * 2;
constexpr size_t WS_MB = WS_SSQ + (size_t)NTOK * 16 * 4;
constexpr size_t WS_KB = WS_MB + (size_t)8192 * 1024 * 2;
constexpr size_t WS_VT = WS_KB + (size_t)NB * NH * NMEM * HD * 2;
constexpr size_t WS_WIN = WS_VT + (size_t)NB * NH * NMEM * HD * 2;
constexpr size_t WS_WKV = WS_WIN + (size_t)2048 * 1024 * 2;
constexpr size_t WS_WGLU = WS_WKV + (size_t)512 * 1024 * 2;
constexpr size_t WS_WOUT = WS_WGLU + (size_t)768 * 384 * 2;
constexpr size_t WS_BS1 = WS_WOUT + (size_t)1024 * 1024 * 2;
constexpr size_t WS_BS2 = WS_BS1 + (size_t)12 * 256 * 1280 * 2;
constexpr size_t WS_LAMT = WS_BS2 + (size_t)24 * 512 * 640 * 2;
constexpr size_t WS_END = WS_LAMT + (size_t)24 * 64 * 2 * 4;

constexpr int LDS_BYTES = 147456;

__device__ __forceinline__ unsigned cvt_pk_bf16(float lo, float hi) { unsigned r; asm volatile("v_cvt_pk_bf16_f32 %0, %1, %2" : "=v"(r) : "v"(lo), "v"(hi)); return r; }
__device__ __forceinline__ bf16_t f2bf(float f) { return (bf16_t)(cvt_pk_bf16(f, 0.f) & 0xffffu); }
__device__ __forceinline__ float bf_lo(unsigned w) { return __uint_as_float(w << 16); }
__device__ __forceinline__ float bf_hi(unsigned w) { return __uint_as_float(w & 0xffff0000u); }
__device__ __forceinline__ float sigmoid_f(float v) { return __builtin_amdgcn_rcpf(1.0f + __builtin_amdgcn_exp2f(-1.44269504f * v)); }
__device__ __forceinline__ float silu_f(float v) { return v * sigmoid_f(v); }
__device__ __forceinline__ float gelu_tanh_f(float v) { const float z = 0.7978845608f * (v + 0.044715f * v * v * v); return v * sigmoid_f(2.0f * z); }

namespace pg8 {
constexpr int BM = 256, BK = 64, HALF = 128, HTB = HALF * BK * 2, STAGE_BYTES = 8 * HTB, NXCD = 8, WGM = 8;
__host__ __device__ __forceinline__ int lds_byte(int r, int c) { const int st = (r >> 4) * 2 + (c >> 5), rr = r & 15, cc = c & 31, ob = rr * 64 + cc * 2; return st * 1024 + (ob ^ (((ob >> 9) & 1) << 5)); }
__host__ __device__ __forceinline__ void stage_rc(int b, int& R, int& C) { const int st = b / 1024, sb = b % 1024, swz = sb ^ (((sb >> 9) & 1) << 5); R = (st >> 1) * 16 + swz / 64; C = (st & 1) * 32 + (swz % 64) / 2; }
__host__ __device__ __forceinline__ int perm32(int rho) { const int n = rho >> 4, i = rho & 15; return 8 * (i >> 2) + 4 * n + (i & 3); }

struct Unit { int pm, pn, aux, pad; size_t aoff, boff; };
struct Gemm { const bf16_t* A; const bf16_t* Bt; int lda, ldb, K; };

struct OrderStd {
    int nM, nN, nwg, G, c; size_t astep, bstep;
    __device__ void init(int M, int N, int lda, int ldb, int G_, int c_) { nM = M / BM; nN = N / BM; nwg = nM * nN; G = G_; c = c_; astep = (size_t)BM * lda * 2; bstep = (size_t)BM * ldb * 2; }
    __device__ bool next(int i, Unit& u) const {
        const long L = (long)i * G + c; if (L >= nwg) return false;
        int wgid = (int)L; { const int q = nwg / NXCD, r = nwg % NXCD, xcd = wgid % NXCD, off = wgid / NXCD; wgid = (xcd < r ? xcd * (q + 1) : r * (q + 1) + (xcd - r) * q) + off; }
        const int nig = WGM * nN, gid = wgid / nig, fm = gid * WGM, gsz = (nM - fm) < WGM ? (nM - fm) : WGM;
        u.pm = fm + ((wgid % nig) % gsz); u.pn = (wgid % nig) / gsz; u.aux = 0; u.pad = 0; u.aoff = (size_t)u.pm * astep; u.boff = (size_t)u.pn * bstep; return true;
    }
};
struct OrderS1 {
    int G, c;
    __device__ bool next(int i, Unit& u) const {
        const long L = (long)i * G + c; if (L >= 96) return false;
        u.pm = (int)L / 12; u.pn = (int)L % 12; u.aux = 0; u.pad = 0;
        u.aoff = ((size_t)u.pm * 256 * UROW + (size_t)u.pn * 1280) * 2; u.boff = (size_t)u.pn * 256 * 1280 * 2; return true;
    }
};
struct OrderS2 {
    int G, c;
    __device__ bool next(int i, Unit& u) const {
        const long L = (long)i * G + c; if (L >= 384) return false;
        const int g = (int)L / 16, rem = (int)L % 16; u.pm = rem >> 1; u.pn = rem & 1; u.aux = g; u.pad = 0;
        u.aoff = ((size_t)u.pm * 256 * UROW + (size_t)g * 640) * 2; u.boff = ((size_t)g * 512 + (size_t)u.pn * 256) * 640 * 2; return true;
    }
};

template <class Epi, class Sched>
__device__ __forceinline__ void gemm_phase(LAS unsigned char* lds, const Gemm g, const Sched& S, const Epi& E) {
    const int tid = threadIdx.x, wid = __builtin_amdgcn_readfirstlane(tid >> 6), lane = tid & 63, wr = wid >> 2, wc = wid & 3, fr = lane & 15, fq = lane >> 4;
    const int K = g.K, nt = K / BK;
    unsigned voffA[2], voffB[2];
#pragma unroll
    for (int i = 0; i < 2; ++i) { int R, C; stage_rc(tid * 16 + i * 8192, R, C); const int Rb = Epi::PERM ? ((R & ~31) + perm32(R & 31)) : R;
        voffA[i] = (unsigned)(R * g.lda + C) * 2u; voffB[i] = (unsigned)(Rb * g.ldb + C) * 2u; }
    const size_t kstep = (size_t)(BK * 2);
    const size_t hstepA = (size_t)HALF * g.lda * 2, hstepB = (size_t)HALF * g.ldb * 2;
    const unsigned ldsw = (unsigned)wid * 1024u;
    const int aoff = lds_byte(wr * 64 + fr, fq * 8), boff = lds_byte(wc * 32 + fr, fq * 8);
#define PG8_SA(b, h) (((b) * 2 + (h)) * HTB)
#define PG8_SB(b, h) ((4 + (b) * 2 + (h)) * HTB)
#define PG8_STAGE(bufoff, gbase, voff) do { _Pragma("unroll") for (int _i = 0; _i < 2; ++_i) \
        __builtin_amdgcn_global_load_lds((const unsigned*)((const char*)(gbase) + (voff)[_i]), (LAS unsigned*)(lds + (bufoff) + ldsw + _i * 8192), 16, 0, 0); } while (0)
#define PG8_LDA(dst, b, h) do { _Pragma("unroll") for (int m = 0; m < 4; ++m) _Pragma("unroll") for (int k = 0; k < 2; ++k) dst[m][k] = *(const LAS bf16x8*)(lds + PG8_SA(b, h) + aoff + m * 2048 + k * 1024); } while (0)
#define PG8_LDB(dst, b, h) do { _Pragma("unroll") for (int n = 0; n < 2; ++n) _Pragma("unroll") for (int k = 0; k < 2; ++k) dst[n][k] = *(const LAS bf16x8*)(lds + PG8_SB(b, h) + boff + n * 2048 + k * 1024); } while (0)
#define PG8_MMA(ai, bj, At, Bt) do { __builtin_amdgcn_s_setprio(1); _Pragma("unroll") for (int m = 0; m < 4; ++m) _Pragma("unroll") for (int n = 0; n < 2; ++n) _Pragma("unroll") for (int k = 0; k < 2; ++k) \
        acc[ai][bj][m][n] = __builtin_amdgcn_mfma_f32_16x16x32_bf16(Bt[n][k], At[m][k], acc[ai][bj][m][n], 0, 0, 0); __builtin_amdgcn_s_setprio(0); } while (0)
#define PG8_WAIT_V(n) asm volatile("s_waitcnt vmcnt(" #n ")" ::: "memory")
#define PG8_WAIT_L(n) asm volatile("s_waitcnt lgkmcnt(" #n ")" ::: "memory")
#define PG8_BAR __builtin_amdgcn_s_barrier()
#define PG8_SCHED __builtin_amdgcn_sched_barrier(0)
    Unit cur, nxt; int ui = 0;
    if (!S.next(0, cur)) return;
    f32x4 acc[2][2][4][2];
#pragma unroll
    for (int a = 0; a < 2; ++a)
#pragma unroll
        for (int b = 0; b < 2; ++b)
#pragma unroll
            for (int m = 0; m < 4; ++m)
#pragma unroll
                for (int n = 0; n < 2; ++n) acc[a][b][m][n] = (f32x4){0.f, 0.f, 0.f, 0.f};
    bf16x8 At[4][2], B0[2][2], B1[2][2];
    const char* cA = (const char*)g.A + cur.aoff; const char* cB = (const char*)g.Bt + cur.boff;
    PG8_STAGE(PG8_SB(0, 0), cB, voffB); PG8_STAGE(PG8_SB(0, 1), cB + hstepB, voffB); PG8_STAGE(PG8_SA(0, 0), cA, voffA); PG8_STAGE(PG8_SA(0, 1), cA + hstepA, voffA);
    if (wr == 1) PG8_BAR;
    PG8_WAIT_V(2); PG8_BAR;
    PG8_STAGE(PG8_SB(1, 0), cB + kstep, voffB); PG8_STAGE(PG8_SA(1, 0), cA + kstep, voffA); PG8_STAGE(PG8_SB(1, 1), cB + hstepB + kstep, voffB);
    PG8_WAIT_V(6); PG8_BAR;
    for (;;) {
        const bool has_next = S.next(ui + 1, nxt);
        const char* nA = has_next ? (const char*)g.A + nxt.aoff : cA; const char* nB = has_next ? (const char*)g.Bt + nxt.boff : cB;
#pragma unroll 1
        for (int t = 0; t < nt; t += 2) {
            const bool last = (t == nt - 2);
            const char* a1 = cA + (size_t)(t + 1) * kstep;
            const char* a2 = last ? nA : cA + (size_t)(t + 2) * kstep; const char* b2 = last ? nB : cB + (size_t)(t + 2) * kstep;
            const char* a3 = a2 + kstep; const char* b3 = b2 + kstep;
            PG8_LDB(B0, 0, 0); PG8_LDB(B1, 0, 1); PG8_SCHED; PG8_LDA(At, 0, 0); PG8_STAGE(PG8_SA(1, 1), a1 + hstepA, voffA);
            PG8_WAIT_V(8); PG8_WAIT_L(0); PG8_BAR; PG8_MMA(0, 0, At, B0); PG8_MMA(0, 1, At, B1); PG8_BAR; PG8_SCHED;
            PG8_LDA(At, 0, 1); PG8_STAGE(PG8_SB(0, 0), b2, voffB); PG8_STAGE(PG8_SB(0, 1), b2 + hstepB, voffB); PG8_STAGE(PG8_SA(0, 0), a2, voffA);
            PG8_WAIT_V(8); PG8_WAIT_L(0); PG8_BAR; PG8_MMA(1, 0, At, B0); PG8_MMA(1, 1, At, B1); PG8_BAR; PG8_SCHED;
            PG8_LDB(B0, 1, 0); PG8_LDB(B1, 1, 1); PG8_SCHED; PG8_LDA(At, 1, 0); PG8_STAGE(PG8_SA(0, 1), a2 + hstepA, voffA);
            PG8_WAIT_V(8); PG8_WAIT_L(0); PG8_BAR; PG8_MMA(0, 0, At, B0); PG8_MMA(0, 1, At, B1); PG8_BAR; PG8_SCHED;
            PG8_LDA(At, 1, 1); PG8_STAGE(PG8_SB(1, 0), b3, voffB); PG8_STAGE(PG8_SB(1, 1), b3 + hstepB, voffB); PG8_STAGE(PG8_SA(1, 0), a3, voffA);
            PG8_WAIT_V(8); PG8_WAIT_L(0); PG8_BAR; PG8_MMA(1, 0, At, B0); PG8_MMA(1, 1, At, B1); PG8_BAR; PG8_SCHED;
        }
        if (wr == 0) PG8_BAR;
        E(acc, cur, wr, wc, fr, fq);
        if (!has_next) break;
#pragma unroll
        for (int a = 0; a < 2; ++a)
#pragma unroll
            for (int b = 0; b < 2; ++b)
#pragma unroll
                for (int m = 0; m < 4; ++m)
#pragma unroll
                    for (int n = 0; n < 2; ++n) acc[a][b][m][n] = (f32x4){0.f, 0.f, 0.f, 0.f};
        cur = nxt; cA = nA; cB = nB; ++ui;
        if (wr == 1) PG8_BAR;
    }
    PG8_WAIT_V(0);
    PG8_BAR;
#undef PG8_SA
#undef PG8_SB
#undef PG8_STAGE
#undef PG8_LDA
#undef PG8_LDB
#undef PG8_MMA
#undef PG8_WAIT_V
#undef PG8_WAIT_L
#undef PG8_BAR
#undef PG8_SCHED
}

typedef f32x4 Acc[2][2][4][2];
__device__ __forceinline__ u32x4 pack8(f32x4 v0, f32x4 v1) { u32x4 w; w.x = cvt_pk_bf16(v0[0], v0[1]); w.y = cvt_pk_bf16(v0[2], v0[3]); w.z = cvt_pk_bf16(v1[0], v1[1]); w.w = cvt_pk_bf16(v1[2], v1[3]); return w; }

struct EpiIn {
    static constexpr bool PERM = true;
    bf16_t* PROJ; bf16_t* UBUF;
    __device__ __forceinline__ void operator()(const Acc& acc, const Unit& u, int wr, int wc, int fr, int fq) const {
#pragma unroll
        for (int bj = 0; bj < 2; ++bj) {
            const int blk = 2 * u.pn + bj, col0 = 128 * blk + 32 * wc + 8 * fq;
#pragma unroll
            for (int ai = 0; ai < 2; ++ai)
#pragma unroll
                for (int m = 0; m < 4; ++m) {
                    const int row = u.pm * BM + ai * HALF + wr * 64 + m * 16 + fr;
                    f32x4 v0 = acc[ai][bj][m][0], v1 = acc[ai][bj][m][1];
                    if (blk >= 8) {
#pragma unroll
                        for (int j = 0; j < 4; ++j) { v0[j] = silu_f(v0[j]); v1[j] = silu_f(v1[j]); }
                    } else if (blk >= 6) { v0 = v0 * 0.18033688f; v1 = v1 * 0.18033688f; }
                    const u32x4 w = pack8(v0, v1);
                    if (blk >= 3 && blk < 6) { const int cc = col0 - 384, gg = cc >> 4, cin = cc & 15;
                        *(u32x4*)(UBUF + (size_t)(row >> 5) * UROW + gg * 640 + (row & 31) * 16 + cin) = w; }
                    else *(u32x4*)(PROJ + (size_t)row * INW + col0) = w;
                }
        }
    }
};
struct EpiS1 {
    static constexpr bool PERM = false;
    float* SEND;
    __device__ __forceinline__ void operator()(const Acc& acc, const Unit& u, int wr, int wc, int fr, int fq) const {
        const int row0 = u.pm * BM + wr * 64 + fr, col0 = u.pn * BM + wc * 32 + 4 * fq;
#pragma unroll
        for (int ai = 0; ai < 2; ++ai)
#pragma unroll
            for (int m = 0; m < 4; ++m) { float* rowp = SEND + (size_t)(row0 + ai * HALF + m * 16) * 3072 + col0;
#pragma unroll
                for (int bj = 0; bj < 2; ++bj)
#pragma unroll
                    for (int n = 0; n < 2; ++n) *(f32x4*)(rowp + bj * HALF + n * 16) = acc[ai][bj][m][n]; }
    }
};
struct EpiKV {
    static constexpr bool PERM = true;
    bf16_t* KB; bf16_t* VT;
    __device__ __forceinline__ void operator()(const Acc& acc, const Unit& u, int wr, int wc, int fr, int fq) const {
#pragma unroll
        for (int bj = 0; bj < 2; ++bj) {
            const int c0 = 128 * bj + 32 * wc + 8 * fq, hh = c0 >> 6, d0 = c0 & 63;
#pragma unroll
            for (int ai = 0; ai < 2; ++ai)
#pragma unroll
                for (int m = 0; m < 4; ++m) {
                    const int row = u.pm * BM + ai * HALF + wr * 64 + m * 16 + fr, b = row >> 8, mm = row & 255;
                    const f32x4 v0 = acc[ai][bj][m][0], v1 = acc[ai][bj][m][1];
                    if (u.pn == 0) *(u32x4*)(KB + ((size_t)(b * NH + hh) * NMEM + mm) * HD + d0) = pack8(v0, v1);
                    else { bf16_t* p = VT + ((size_t)(b * NH + hh) * HD + d0) * NMEM + mm;
#pragma unroll
                        for (int j = 0; j < 4; ++j) { p[j * NMEM] = f2bf(v0[j]); p[(4 + j) * NMEM] = f2bf(v1[j]); } }
                }
        }
    }
};
struct EpiS2 {
    static constexpr bool PERM = true;
    bf16_t* YB;
    __device__ __forceinline__ void operator()(const Acc& acc, const Unit& u, int wr, int wc, int fr, int fq) const {
#pragma unroll
        for (int bj = 0; bj < 2; ++bj) {
            const int j0 = u.pn * BM + 128 * bj + 32 * wc + 8 * fq, t = j0 >> 4, cp = j0 & 15;
#pragma unroll
            for (int ai = 0; ai < 2; ++ai)
#pragma unroll
                for (int m = 0; m < 4; ++m) {
                    const int row = u.pm * BM + ai * HALF + wr * 64 + m * 16 + fr;
                    f32x4 v0 = acc[ai][bj][m][0], v1 = acc[ai][bj][m][1];
#pragma unroll
                    for (int j = 0; j < 4; ++j) { v0[j] = gelu_tanh_f(v0[j]); v1[j] = gelu_tanh_f(v1[j]); }
                    *(u32x4*)(YB + ((size_t)row * CT + t) * SSMW + u.aux * SG + cp) = pack8(v0, v1);
                }
        }
    }
};
struct EpiGlu {
    static constexpr bool PERM = true;
    const bf16_t* PROJ; bf16_t* GB;
    __device__ __forceinline__ void operator()(const Acc& acc, const Unit& u, int wr, int wc, int fr, int fq) const {
        const int jj0 = (u.pn * BM + 32 * wc + 8 * fq) >> 1;
        const unsigned row0 = (unsigned)(u.pm * BM + wr * 64 + fr);
        const unsigned goff0 = (row0 * INW + 1024 + 384 + jj0) * 2u, ooff0 = (row0 * DM + 384 + jj0) * 2u;
#pragma unroll
        for (int ai = 0; ai < 2; ++ai)
#pragma unroll
            for (int m = 0; m < 4; ++m) {
                const unsigned goff = goff0 + (unsigned)(ai * HALF + m * 16) * INW * 2u, ooff = ooff0 + (unsigned)(ai * HALF + m * 16) * DM * 2u;
#pragma unroll
                for (int bj = 0; bj < 2; ++bj) {
                    const f32x4 z1 = acc[ai][bj][m][0], z2 = acc[ai][bj][m][1];
                    const u32x2 sg = *(const u32x2*)((const char*)PROJ + (goff + 128u * bj));
                    const float o0 = z1[0] * sigmoid_f(z2[0]) * bf_lo(sg.x), o1 = z1[1] * sigmoid_f(z2[1]) * bf_hi(sg.x);
                    const float o2 = z1[2] * sigmoid_f(z2[2]) * bf_lo(sg.y), o3 = z1[3] * sigmoid_f(z2[3]) * bf_hi(sg.y);
                    u32x2 w; w.x = cvt_pk_bf16(o0, o1); w.y = cvt_pk_bf16(o2, o3);
                    *(u32x2*)((char*)GB + (ooff + 128u * bj)) = w;
                }
                asm volatile("" ::: "memory");
            }
    }
};
struct EpiOut {
    static constexpr bool PERM = true;
    bf16_t* OB; float* SSQ;
    __device__ __forceinline__ void operator()(const Acc& acc, const Unit& u, int wr, int wc, int fr, int fq) const {
#pragma unroll
        for (int ai = 0; ai < 2; ++ai)
#pragma unroll
            for (int m = 0; m < 4; ++m) {
                const int row = u.pm * BM + ai * HALF + wr * 64 + m * 16 + fr;
                float s = 0.f;
#pragma unroll
                for (int bj = 0; bj < 2; ++bj) {
                    const int col0 = u.pn * BM + 128 * bj + 32 * wc + 8 * fq;
                    const f32x4 v0 = acc[ai][bj][m][0], v1 = acc[ai][bj][m][1];
                    s += (v0[0] * v0[0] + v0[1] * v0[1]) + (v0[2] * v0[2] + v0[3] * v0[3]) + (v1[0] * v1[0] + v1[1] * v1[1]) + (v1[2] * v1[2] + v1[3] * v1[3]);
                    *(u32x4*)(OB + (size_t)row * DM + col0) = pack8(v0, v1);
                }
                s += __shfl_xor(s, 16); s += __shfl_xor(s, 32);
                if (fq == 0) SSQ[(size_t)row * 16 + u.pn * 4 + wc] = s;
            }
    }
};
}

struct Args {
    const float* x; const float* mem; const float* g_pre; const float* w_in; const float* w_pool; const float* pool_scale;
    const float* a_re; const float* a_im; const float* log_dt; const float* b_re; const float* b_im; const float* c_re; const float* c_im;
    const float* d_skip; const float* w_glu; const float* g_mem; const float* w_kv; const float* w_out; const float* g_post;
    float* out; unsigned char* ws; int ph_lo, ph_hi;
};

__device__ __forceinline__ float wave_sum(float v) {
    v += __shfl_xor(v, 32); v += __shfl_xor(v, 16); v += __shfl_xor(v, 8); v += __shfl_xor(v, 4); v += __shfl_xor(v, 2); v += __shfl_xor(v, 1); return v;
}

__device__ __forceinline__ void rmsnorm_rows(const float* src, const float* g, bf16_t* dst, int nrows, int gwave, int nwaves, int lane) {
    for (int row = gwave; row < nrows; row += nwaves) {
        const f32x4* p = (const f32x4*)(src + (size_t)row * DM);
        f32x4 v[4]; float ss = 0.f;
#pragma unroll
        for (int i = 0; i < 4; ++i) { v[i] = p[lane + 64 * i]; ss += (v[i][0] * v[i][0] + v[i][1] * v[i][1]) + (v[i][2] * v[i][2] + v[i][3] * v[i][3]); }
        ss = wave_sum(ss);
        const float rs = rsqrtf(ss * (1.0f / DM) + EPS);
#pragma unroll
        for (int i = 0; i < 4; ++i) { const f32x4 gv = ((const f32x4*)g)[lane + 64 * i];
            u32x2 w; w.x = cvt_pk_bf16(v[i][0] * rs * gv[0], v[i][1] * rs * gv[1]); w.y = cvt_pk_bf16(v[i][2] * rs * gv[2], v[i][3] * rs * gv[3]);
            *(u32x2*)(dst + (size_t)row * DM + 4 * (lane + 64 * i)) = w; }
    }
}

template <int MODE>
__device__ __forceinline__ void tr_tile(const float* src, int ld_src, int k0, int n0, bf16_t* dst, int ld_dst, LAS float* tile, int tid) {
    __syncthreads();
    for (int e = tid; e < 4096; e += 512) { const int kk = e >> 6, nn = e & 63; tile[kk * 65 + nn] = src[(size_t)(k0 + kk) * ld_src + n0 + nn]; }
    __syncthreads();
    for (int e = tid; e < 4096; e += 512) { const int nn = e >> 6, kk = e & 63; int n = n0 + nn;
        if (MODE == 1) { n = (n < 384) ? (8 * (n >> 2) + (n & 3)) : (8 * ((n - 384) >> 2) + 4 + ((n - 384) & 3)); }
        dst[(size_t)n * ld_dst + k0 + kk] = f2bf(tile[kk * 65 + nn]); }
}

__global__ void __launch_bounds__(512, 2) mega(Args a) {
    extern __shared__ __attribute__((aligned(16))) unsigned char lds_raw[];
    LAS unsigned char* lds = (LAS unsigned char*)lds_raw;
    const int G = gridDim.x, bid = blockIdx.x;
#define TIDS int tid = threadIdx.x; asm volatile("" : "+v"(tid)); const int lane = tid & 63, wave = tid >> 6; (void)lane; (void)wave
#define WSP unsigned char* ws = a.ws; asm volatile("" : "+s"(ws))
#define HB ((bf16_t*)(ws + WS_HB))
#define GBUF ((bf16_t*)(ws + WS_HB))
#define PROJ ((bf16_t*)(ws + WS_PROJ))
#define OBUF ((bf16_t*)(ws + WS_PROJ))
#define UBUF ((bf16_t*)(ws + WS_UBUF))
#define SEND ((float*)(ws + WS_SEND))
#define YBUF ((bf16_t*)(ws + WS_YBUF))
#define SSQ ((float*)(ws + WS_SSQ))
#define MBF ((bf16_t*)(ws + WS_MB))
#define KB ((bf16_t*)(ws + WS_KB))
#define VT ((bf16_t*)(ws + WS_VT))
#define WIN ((bf16_t*)(ws + WS_WIN))
#define WKV ((bf16_t*)(ws + WS_WKV))
#define WGLU ((bf16_t*)(ws + WS_WGLU))
#define WOUT ((bf16_t*)(ws + WS_WOUT))
#define BS1 ((bf16_t*)(ws + WS_BS1))
#define BS2 ((bf16_t*)(ws + WS_BS2))
#define LAMT ((float*)(ws + WS_LAMT))
    const int lo = a.ph_lo, hi = a.ph_hi;
#ifndef PH_MASK
#define PH_MASK 0xff
#endif
#define IN(k) (((PH_MASK >> (k)) & 1) && lo <= (k) && (k) < hi)
#define SEAM(k) do { if (IN(k) && IN((k) + 1)) { cg::this_grid().sync(); } } while (0)

    if (IN(0)) {
        WSP;
        TIDS;
        LAS float* sm = (LAS float*)lds;
        constexpr int N_SSM = NG * CT, N_TRIN = 26 * 16, N_TROUT = 256, N_TRGLU = 72, N_TRKV = 128, N_FOLD = 64;
        constexpr int I1 = N_SSM, I2 = I1 + N_TRIN, I3 = I2 + N_TROUT, I4 = I3 + N_TRGLU, I5 = I4 + N_TRKV, I6 = I5 + N_FOLD;
        for (int item = bid; item < I6; item += G) {
            if (item < I1) {
                const int g = item / CT, j = item % CT;
                __syncthreads();
                if (tid < 64) {
                    const int n = tid; const float ar = a.a_re[g * SN + n], ai = a.a_im[g * SN + n], dt = expf(a.log_dt[g]);
                    const float xr = ar * dt, yi = ai * dt;
                    float s0, c0, s1, c1, sy, cy;
                    const float m0 = expf((float)j * xr); sincosf((float)j * yi, &s0, &c0);
                    const float m1 = expf((float)(j + 1) * xr); sincosf((float)(j + 1) * yi, &s1, &c1);
                    const float e1 = expm1f(xr); sincosf(yi, &sy, &cy); const float sh = sinf(0.5f * yi);
                    const float br = e1 * cy - 2.f * sh * sh, bi = (e1 + 1.f) * sy;
                    const float den = 1.f / (ar * ar + ai * ai);
                    const float cr = (br * ar + bi * ai) * den, ci = (bi * ar - br * ai) * den;
                    const float ljr = m0 * c0, lji = m0 * s0;
                    sm[n] = ljr; sm[64 + n] = lji; sm[128 + n] = m1 * c1; sm[192 + n] = m1 * s1;
                    sm[256 + n] = ljr * cr - lji * ci; sm[320 + n] = ljr * ci + lji * cr;
                    if (j == CT - 1) { LAMT[(g * SN + n) * 2] = m1 * c1; LAMT[(g * SN + n) * 2 + 1] = m1 * s1; }
                }
                __syncthreads();
                bf16_t* bs2 = BS2 + (size_t)g * 512 * 640;
                if (tid < 256) {
                    const int cp = tid >> 4, c = tid & 15; float kv = 0.f;
                    for (int n = 0; n < SN; ++n) {
                        const float Br = a.b_re[((size_t)g * SN + n) * SG + c], Bi = a.b_im[((size_t)g * SN + n) * SG + c];
                        const float Cr = a.c_re[((size_t)g * SG + cp) * SN + n], Ci = a.c_im[((size_t)g * SG + cp) * SN + n];
                        const float lr = sm[256 + n], li = sm[320 + n];
                        const float pr = lr * Br - li * Bi, pi = lr * Bi + li * Br;
                        kv += Cr * pr - Ci * pi;
                    }
                    if (j == 0 && c == cp) kv += a.d_skip[g * SG + cp];
                    const bf16_t kb = f2bf(kv);
                    for (int t = j; t < CT; ++t) { const int s = t - j;
                        bs2[(size_t)(t * SG + cp) * 640 + s * SG + c] = kb;
                        if (j > 0) bs2[(size_t)(s * SG + cp) * 640 + t * SG + c] = 0; }
                } else {
#pragma unroll
                    for (int r = 0; r < 4; ++r) { const int idx = (tid - 256) + 256 * r, cp = idx >> 6, n = idx & 63;
                        const float Cr = a.c_re[((size_t)g * SG + cp) * SN + n], Ci = a.c_im[((size_t)g * SG + cp) * SN + n];
                        const float lr = sm[128 + n], li = sm[192 + n];
                        bs2[(size_t)(j * SG + cp) * 640 + 512 + n] = f2bf(Cr * lr - Ci * li);
                        bs2[(size_t)(j * SG + cp) * 640 + 576 + n] = f2bf(-(Cr * li + Ci * lr)); }
                }
                {
                    const int s = CT - 1 - j, p = g >> 1, gl = g & 1;
                    bf16_t* bs1 = BS1 + (size_t)p * 256 * 1280;
#pragma unroll
                    for (int r = 0; r < 2; ++r) { const int idx = tid + 512 * r, n = idx >> 4, c = idx & 15;
                        const float Br = a.b_re[((size_t)g * SN + n) * SG + c], Bi = a.b_im[((size_t)g * SN + n) * SG + c];
                        const float lr = sm[256 + n], li = sm[320 + n];
                        bs1[(size_t)(gl * 128 + n) * 1280 + gl * 640 + s * SG + c] = f2bf(lr * Br - li * Bi);
                        bs1[(size_t)(gl * 128 + 64 + n) * 1280 + gl * 640 + s * SG + c] = f2bf(lr * Bi + li * Br); }
                    for (int idx = tid; idx < 128 * 24; idx += 512) { const int rr = idx / 24, q = idx % 24; int col;
                        if (q < 16) col = (1 - gl) * 640 + s * SG + q; else if (q < 20) col = gl * 640 + 512 + 4 * s + (q - 16); else col = (1 - gl) * 640 + 512 + 4 * s + (q - 20);
                        bs1[(size_t)(gl * 128 + rr) * 1280 + col] = 0; }
                }
            } else if (item < I2) { const int it = item - I1, ntl = it / 16, kt = it % 16; tr_tile<0>(a.w_in, INW, 64 * kt, 384 + 64 * ntl, WIN, DM, sm, tid); }
            else if (item < I3) { const int it = item - I2, ntl = it / 16, kt = it % 16; tr_tile<0>(a.w_out, DM, 64 * kt, 64 * ntl, WOUT, DM, sm, tid); }
            else if (item < I4) { const int it = item - I3, ntl = it / 6, kt = it % 6; tr_tile<1>(a.w_glu, 768, 64 * kt, 64 * ntl, WGLU, 384, sm, tid); }
            else if (item < I5) { const int it = item - I4, ntl = it / 16, kt = it % 16; tr_tile<0>(a.w_kv, 512, 64 * kt, 64 * ntl, WKV, DM, sm, tid); }
            else {
                const int it = item - I5, kt = it >> 2, gi = it & 3, k0 = 64 * kt;
                LAS float* At = sm; LAS float* Wp = sm + 64 * 97;
                __syncthreads();
                for (int e = tid; e < 64 * 96; e += 512) { const int kk = e / 96, c = e % 96; At[kk * 97 + c] = a.w_in[(size_t)(k0 + kk) * INW + gi * 96 + c]; }
                for (int e = tid; e < 96 * 96; e += 512) Wp[e] = a.w_pool[(size_t)gi * 9216 + e];
                __syncthreads();
                const int kk = tid & 63, d0 = (tid >> 6) * 12;
                float ac[12];
#pragma unroll
                for (int i = 0; i < 12; ++i) ac[i] = 0.f;
                for (int c = 0; c < 96; ++c) { const float av = At[kk * 97 + c];
#pragma unroll
                    for (int i = 0; i < 12; ++i) ac[i] += av * Wp[c * 96 + d0 + i]; }
#pragma unroll
                for (int i = 0; i < 12; ++i) { const int d = gi * 96 + d0 + i; WIN[(size_t)d * DM + k0 + kk] = f2bf(ac[i] * a.pool_scale[d]); }
            }
        }
        for (int idx = bid * 512 + tid; idx < NRC * NG * 16; idx += G * 512) { const int row = idx / (NG * 16), rem = idx % (NG * 16), g = rem >> 4, q = rem & 15;
            *(u32x4*)(UBUF + (size_t)row * UROW + g * 640 + 512 + q * 8) = (u32x4){0u, 0u, 0u, 0u}; }
        rmsnorm_rows(a.mem, a.g_mem, MBF, NB * NMEM, bid * 8 + wave, G * 8, lane);
        rmsnorm_rows(a.x, a.g_pre, HB, NTOK, bid * 8 + wave, G * 8, lane);
    }
    SEAM(0);

    if (IN(1)) {
        WSP;
        pg8::Gemm g{HB, WIN, DM, DM, DM}; pg8::OrderStd S; S.init(NTOK, INW, DM, DM, G, bid);
        pg8::EpiIn E{PROJ, UBUF};
        pg8::gemm_phase<pg8::EpiIn, pg8::OrderStd>(lds, g, S, E);
    }
    SEAM(1);

    if (IN(2)) {
        WSP;
        { pg8::Gemm g{UBUF, BS1, UROW, 1280, 1280}; pg8::OrderS1 S{G, bid}; pg8::EpiS1 E{SEND};
          pg8::gemm_phase<pg8::EpiS1, pg8::OrderS1>(lds, g, S, E); }
        { pg8::Gemm g{MBF, WKV, DM, DM, DM}; pg8::OrderStd S; S.init(NB * NMEM, 512, DM, DM, G, (bid + 160) % G); pg8::EpiKV E{KB, VT};
          pg8::gemm_phase<pg8::EpiKV, pg8::OrderStd>(lds, g, S, E); }
    }
    SEAM(2);

    if (IN(3)) {
        WSP;
        TIDS;
        for (int idx = bid * 512 + tid; idx < NB * NG * SN; idx += G * 512) {
            const int b = idx / (NG * SN), rem = idx % (NG * SN), g = rem >> 6, n = rem & 63;
            const float lr = LAMT[(g * SN + n) * 2], li = LAMT[(g * SN + n) * 2 + 1];
            float hr = 0.f, hi2 = 0.f;
            for (int k = 0; k < NCH; ++k) {
                const size_t row = (size_t)b * NCH + k;
                UBUF[row * UROW + g * 640 + 512 + n] = f2bf(hr); UBUF[row * UROW + g * 640 + 576 + n] = f2bf(hi2);
                const float sr = SEND[row * 3072 + g * 128 + n], si = SEND[row * 3072 + g * 128 + 64 + n];
                const float nr = lr * hr - li * hi2 + sr, ni = lr * hi2 + li * hr + si; hr = nr; hi2 = ni;
            }
        }
    }
    SEAM(3);

    if (IN(4)) {
        WSP;
        { pg8::Gemm g{UBUF, BS2, UROW, 640, 640}; pg8::OrderS2 S{G, bid}; pg8::EpiS2 E{YBUF};
          pg8::gemm_phase<pg8::EpiS2, pg8::OrderS2>(lds, g, S, E); }
        TIDS;
        for (int it = bid * 512 + tid; it < (NTOK / 16) * 48; it += G * 512) {
            const int run = it / 48, cgp = it % 48, b = run >> 7, t0 = (run & 127) * 16, gi = cgp / 12, w = 2 << gi;
            const bf16_t* zb = PROJ + (size_t)b * SEQ * INW + 8 * cgp;
            float S[8];
#pragma unroll
            for (int k = 0; k < 8; ++k) S[k] = 0.f;
            for (int i = 1; i < w; ++i) { const int tt = t0 - i; if (tt >= 0) { const u32x4 v = *(const u32x4*)(zb + (size_t)tt * INW);
                S[0] += bf_lo(v.x); S[1] += bf_hi(v.x); S[2] += bf_lo(v.y); S[3] += bf_hi(v.y); S[4] += bf_lo(v.z); S[5] += bf_hi(v.z); S[6] += bf_lo(v.w); S[7] += bf_hi(v.w); } }
            for (int dt = 0; dt < 16; ++dt) {
                const int t = t0 + dt; const u32x4 v = *(const u32x4*)(zb + (size_t)t * INW);
                float z[8] = {bf_lo(v.x), bf_hi(v.x), bf_lo(v.y), bf_hi(v.y), bf_lo(v.z), bf_hi(v.z), bf_lo(v.w), bf_hi(v.w)};
                const float inv = 1.0f / (float)((t + 1) < w ? (t + 1) : w);
                const u32x4 gv = *(const u32x4*)(PROJ + ((size_t)b * SEQ + t) * INW + 1024 + 8 * cgp);
                const float sg[8] = {bf_lo(gv.x), bf_hi(gv.x), bf_lo(gv.y), bf_hi(gv.y), bf_lo(gv.z), bf_hi(gv.z), bf_lo(gv.w), bf_hi(gv.w)};
                float o[8];
#pragma unroll
                for (int k = 0; k < 8; ++k) { S[k] += z[k]; o[k] = (S[k] * inv - z[k]) * sg[k]; }
                u32x4 wv; wv.x = cvt_pk_bf16(o[0], o[1]); wv.y = cvt_pk_bf16(o[2], o[3]); wv.z = cvt_pk_bf16(o[4], o[5]); wv.w = cvt_pk_bf16(o[6], o[7]);
                *(u32x4*)(GBUF + ((size_t)b * SEQ + t) * DM + 8 * cgp) = wv;
                const int tr = t - w + 1;
                if (tr >= 0) { const u32x4 r = *(const u32x4*)(zb + (size_t)tr * INW);
                    S[0] -= bf_lo(r.x); S[1] -= bf_hi(r.x); S[2] -= bf_lo(r.y); S[3] -= bf_hi(r.y); S[4] -= bf_lo(r.z); S[5] -= bf_hi(r.z); S[6] -= bf_lo(r.w); S[7] -= bf_hi(r.w); }
            }
        }
    }
    SEAM(4);

    if (IN(5)) {
        WSP;
#ifndef NO_GLU
        { pg8::Gemm g{YBUF, WGLU, SSMW, SSMW, SSMW}; pg8::OrderStd S; S.init(NTOK, 768, SSMW, SSMW, G, bid); pg8::EpiGlu E{PROJ, GBUF};
          pg8::gemm_phase<pg8::EpiGlu, pg8::OrderStd>(lds, g, S, E); }
#endif
#ifndef NO_ATT
        TIDS;
        constexpr int VOFF = 256 * 144;
        const int fr = lane & 15, fq = lane >> 4;
        for (int item = bid; item < NB * 16 * NH; item += G) {
            const int b = item >> 6, rem = item & 63, h = rem & 3, tile = rem >> 2;
            const bf16_t* Kg = KB + (size_t)(b * NH + h) * NMEM * HD; const bf16_t* Vg = VT + (size_t)(b * NH + h) * HD * NMEM;
            __syncthreads();
            for (int e = tid; e < 2048; e += 512) { const int m = e >> 3, dc = e & 7; const u32x4 v = *(const u32x4*)(Kg + m * HD + dc * 8);
                const int slot = (m & ~31) + 16 * ((m >> 2) & 1) + 4 * ((m >> 3) & 3) + (m & 3);
                *(LAS u32x4*)(lds + slot * 144 + dc * 16) = v; }
            for (int e = tid; e < 2048; e += 512) { const int d = e >> 5, mc = e & 31; const u32x4 v = *(const u32x4*)(Vg + d * NMEM + mc * 8);
                *(LAS u32x4*)(lds + VOFF + d * 528 + mc * 16) = v; }
            __syncthreads();
            const size_t token = (size_t)b * SEQ + tile * 128 + wave * 16 + fr;
            bf16x8 qf[2];
#pragma unroll
            for (int kk = 0; kk < 2; ++kk) qf[kk] = *(const bf16x8*)(PROJ + token * INW + 768 + h * HD + 32 * kk + 8 * fq);
            f32x4 s[8][2];
            float mx = -3.0e38f;
#pragma unroll
            for (int blk = 0; blk < 8; ++blk)
#pragma unroll
                for (int sub = 0; sub < 2; ++sub) {
                    f32x4 ac = (f32x4){0.f, 0.f, 0.f, 0.f};
#pragma unroll
                    for (int kk = 0; kk < 2; ++kk) { const bf16x8 af = *(const LAS bf16x8*)(lds + (32 * blk + 16 * sub + fr) * 144 + (32 * kk + 8 * fq) * 2);
                        ac = __builtin_amdgcn_mfma_f32_16x16x32_bf16(af, qf[kk], ac, 0, 0, 0); }
                    s[blk][sub] = ac;
                    mx = fmaxf(mx, fmaxf(fmaxf(ac[0], ac[1]), fmaxf(ac[2], ac[3])));
                }
            mx = fmaxf(mx, __shfl_xor(mx, 16)); mx = fmaxf(mx, __shfl_xor(mx, 32));
            float sum = 0.f; bf16x8 pb[8];
#pragma unroll
            for (int blk = 0; blk < 8; ++blk) {
                f32x4 p0, p1;
#pragma unroll
                for (int j = 0; j < 4; ++j) { p0[j] = __builtin_amdgcn_exp2f(s[blk][0][j] - mx); p1[j] = __builtin_amdgcn_exp2f(s[blk][1][j] - mx); }
                sum += (p0[0] + p0[1]) + (p0[2] + p0[3]) + (p1[0] + p1[1]) + (p1[2] + p1[3]);
                const u32x4 pw = pg8::pack8(p0, p1); pb[blk] = __builtin_bit_cast(bf16x8, pw);
            }
            sum += __shfl_xor(sum, 16); sum += __shfl_xor(sum, 32);
            const float inv = 1.0f / sum;
#pragma unroll
            for (int dt = 0; dt < 4; ++dt) {
                f32x4 o = (f32x4){0.f, 0.f, 0.f, 0.f};
#pragma unroll
                for (int blk = 0; blk < 8; ++blk) { const bf16x8 vf = *(const LAS bf16x8*)(lds + VOFF + (16 * dt + fr) * 528 + (32 * blk + 8 * fq) * 2);
                    o = __builtin_amdgcn_mfma_f32_16x16x32_bf16(vf, pb[blk], o, 0, 0, 0); }
                const int d0 = 16 * dt + 4 * fq;
                const u32x2 sg = *(const u32x2*)(PROJ + token * INW + 1024 + 768 + h * HD + d0);
                u32x2 wv; wv.x = cvt_pk_bf16(o[0] * inv * bf_lo(sg.x), o[1] * inv * bf_hi(sg.x)); wv.y = cvt_pk_bf16(o[2] * inv * bf_lo(sg.y), o[3] * inv * bf_hi(sg.y));
                *(u32x2*)(GBUF + token * DM + 768 + h * HD + d0) = wv;
            }
        }
#endif
    }
    SEAM(5);

    if (IN(6)) {
        WSP;
        pg8::Gemm g{GBUF, WOUT, DM, DM, DM}; pg8::OrderStd S; S.init(NTOK, DM, DM, DM, G, bid); pg8::EpiOut E{OBUF, SSQ};
        pg8::gemm_phase<pg8::EpiOut, pg8::OrderStd>(lds, g, S, E);
    }
    SEAM(6);

    if (IN(7)) {
        WSP;
        TIDS;
        for (int row = bid * 8 + wave; row < NTOK; row += G * 8) {
            float ss = (lane < 16) ? SSQ[(size_t)row * 16 + lane] : 0.f;
            ss = wave_sum(ss);
            const float rs = rsqrtf(ss * (1.0f / DM) + EPS);
#pragma unroll
            for (int i = 0; i < 4; ++i) { const int c = 4 * (lane + 64 * i);
                const u32x2 ov = *(const u32x2*)(OBUF + (size_t)row * DM + c);
                const f32x4 xv = *(const f32x4*)(a.x + (size_t)row * DM + c); const f32x4 gv = *(const f32x4*)(a.g_post + c);
                f32x4 r; r[0] = xv[0] + bf_lo(ov.x) * rs * gv[0]; r[1] = xv[1] + bf_hi(ov.x) * rs * gv[1]; r[2] = xv[2] + bf_lo(ov.y) * rs * gv[2]; r[3] = xv[3] + bf_hi(ov.y) * rs * gv[3];
                *(f32x4*)(a.out + (size_t)row * DM + c) = r; }
        }
    }
#undef IN
#undef SEAM
}

extern "C" void kernel_launch(void* const* d_in, const int* in_sizes, int n_in, void* d_out, int out_size, void* d_ws, size_t ws_size, hipStream_t stream) {
    static int grid = 0;
    if (grid == 0) {
        if (n_in != 19 || ws_size < WS_END) { fprintf(stderr, "kernel_launch: unexpected inputs (n_in %d, ws %zu < %zu)\n", n_in, ws_size, (size_t)WS_END); grid = -1; return; }
        int dev = 0, cus = 0, per_cu = 0;
        hipGetDevice(&dev); hipDeviceGetAttribute(&cus, hipDeviceAttributeMultiprocessorCount, dev);
        if (hipFuncSetAttribute((const void*)mega, hipFuncAttributeMaxDynamicSharedMemorySize, LDS_BYTES) != hipSuccess) { fprintf(stderr, "kernel_launch: hipFuncSetAttribute failed\n"); grid = -1; return; }
        if (hipOccupancyMaxActiveBlocksPerMultiprocessor(&per_cu, (const void*)mega, 512, LDS_BYTES) != hipSuccess || per_cu < 1) { fprintf(stderr, "kernel_launch: occupancy query says %d\n", per_cu); per_cu = 1; }
        (void)hipGetLastError();
        grid = cus;
    }
    if (grid < 0) return;
    Args a{};
    a.x = (const float*)d_in[0]; a.mem = (const float*)d_in[1]; a.g_pre = (const float*)d_in[2]; a.w_in = (const float*)d_in[3]; a.w_pool = (const float*)d_in[4];
    a.pool_scale = (const float*)d_in[5]; a.a_re = (const float*)d_in[6]; a.a_im = (const float*)d_in[7]; a.log_dt = (const float*)d_in[8]; a.b_re = (const float*)d_in[9];
    a.b_im = (const float*)d_in[10]; a.c_re = (const float*)d_in[11]; a.c_im = (const float*)d_in[12]; a.d_skip = (const float*)d_in[13]; a.w_glu = (const float*)d_in[14];
    a.g_mem = (const float*)d_in[15]; a.w_kv = (const float*)d_in[16]; a.w_out = (const float*)d_in[17]; a.g_post = (const float*)d_in[18];
    a.out = (float*)d_out; a.ws = (unsigned char*)d_ws;
#if ONE_LAUNCH
    a.ph_lo = 0; a.ph_hi = 8;
    void* args[] = {&a};
    hipError_t e = hipLaunchCooperativeKernel((const void*)mega, dim3(grid), dim3(512), args, LDS_BYTES, stream);
    if (e != hipSuccess) fprintf(stderr, "kernel_launch: cooperative launch failed: %s (grid %d)\n", hipGetErrorString(e), grid);
#else
    for (int p = 0; p < 8; ++p) { a.ph_lo = p; a.ph_hi = p + 1; hipLaunchKernelGGL(mega, dim3(grid), dim3(512), LDS_BYTES, stream, a); }
#endif
}
```

```cpp
#include <hip/hip_runtime.h>
#include <hip/hip_cooperative_groups.h>
#include <cstdio>
#include <cstdint>
namespace cg = cooperative_groups;

#ifndef ONE_LAUNCH
#define ONE_LAUNCH 1
#endif

#define LAS __attribute__((address_space(3)))
typedef unsigned short bf16_t;
typedef short bf16x8 __attribute__((ext_vector_type(8)));
typedef float f32x4 __attribute__((ext_vector_type(4)));
typedef unsigned u32x4 __attribute__((ext_vector_type(4)));
typedef unsigned u32x2 __attribute__((ext_vector_type(2)));

constexpr int NB = 32, SEQ = 2048, DM = 1024, NTOK = NB * SEQ;
constexpr int POOLW = 384, SSMW = 384, ATTW = 256, INW = 2048;
constexpr int NG = 24, SN = 64, SG = 16;
constexpr int CT = 32, NCH = SEQ / CT, NRC = NB * NCH;
constexpr int UK = CT * SG;
constexpr int UROW = NG * 640 + 64;
constexpr int NMEM = 256, NH = 4, HD = 64;
constexpr float EPS = 1e-6f;

constexpr size_t MB_ = 1024 * 1024;
constexpr size_t WS_HB = 0;
constexpr size_t WS_PROJ = WS_HB + 128 * MB_;
constexpr size_t WS_UBUF = WS_PROJ + 256 * MB_;
constexpr size_t WS_SEND = WS_UBUF + (size_t)NRC * UROW * 2;
constexpr size_t WS_YBUF = WS_SEND + (size_t)NRC * 3072 * 4;
constexpr size_t WS_SSQ = WS_YBUF + (size_t)NTOK * 384 * 2;
constexpr size_t WS_MB = WS_SSQ + (size_t)NTOK * 16 * 4;
constexpr size_t WS_KB = WS_MB + (size_t)8192 * 1024 * 2;
constexpr size_t WS_VT = WS_KB + (size_t)NB * NH * NMEM * HD * 2;
constexpr size_t WS_WIN = WS_VT + (size_t)NB * NH * NMEM * HD * 2;
constexpr size_t WS_WKV = WS_WIN + (size_t)2048 * 1024 * 2;
constexpr size_t WS_WGLU = WS_WKV + (size_t)512 * 1024 * 2;
constexpr size_t WS_WOUT = WS_WGLU + (size_t)768 * 384 * 2;
constexpr size_t WS_BS1 = WS_WOUT + (size_t)1024 * 1024 * 2;
constexpr size_t WS_BS2 = WS_BS1 + (size_t)12 * 256 * 1280 * 2;
constexpr size_t WS_LAMT = WS_BS2 + (size_t)24 * 512 * 640 * 2;
constexpr size_t WS_CTL = WS_LAMT + (size_t)24 * 64 * 2 * 4;
constexpr size_t CTL_BYTES = 16384;
constexpr size_t WS_END = WS_CTL + CTL_BYTES;

constexpr int LDS_BYTES = 147456;

__device__ __forceinline__ unsigned cvt_pk_bf16(float lo, float hi) { unsigned r; asm volatile("v_cvt_pk_bf16_f32 %0, %1, %2" : "=v"(r) : "v"(lo), "v"(hi)); return r; }
__device__ __forceinline__ bf16_t f2bf(float f) { return (bf16_t)(cvt_pk_bf16(f, 0.f) & 0xffffu); }
__device__ __forceinline__ float bf_lo(unsigned w) { return __uint_as_float(w << 16); }
__device__ __forceinline__ float bf_hi(unsigned w) { return __uint_as_float(w & 0xffff0000u); }
__device__ __forceinline__ float sigmoid_f(float v) { return __builtin_amdgcn_rcpf(1.0f + __builtin_amdgcn_exp2f(-1.44269504f * v)); }
__device__ __forceinline__ float silu_f(float v) { return v * sigmoid_f(v); }
__device__ __forceinline__ float gelu_tanh_f(float v) { const float z = 0.7978845608f * (v + 0.044715f * v * v * v); return v * sigmoid_f(2.0f * z); }

namespace pg8 {
constexpr int BM = 256, BK = 64, HALF = 128, HTB = HALF * BK * 2, STAGE_BYTES = 8 * HTB, NXCD = 8, WGM = 8;
__host__ __device__ __forceinline__ int lds_byte(int r, int c) { const int st = (r >> 4) * 2 + (c >> 5), rr = r & 15, cc = c & 31, ob = rr * 64 + cc * 2; return st * 1024 + (ob ^ (((ob >> 9) & 1) << 5)); }
__host__ __device__ __forceinline__ void stage_rc(int b, int& R, int& C) { const int st = b / 1024, sb = b % 1024, swz = sb ^ (((sb >> 9) & 1) << 5); R = (st >> 1) * 16 + swz / 64; C = (st & 1) * 32 + (swz % 64) / 2; }
__host__ __device__ __forceinline__ int perm32(int rho) { const int n = rho >> 4, i = rho & 15; return 8 * (i >> 2) + 4 * n + (i & 3); }

struct Unit { int pm, pn, aux, pad; size_t aoff, boff; };
struct Gemm { const bf16_t* A; const bf16_t* Bt; int lda, ldb, K; };

struct OrderStd {
    int nM, nN, nwg, G, c; size_t astep, bstep;
    __device__ void init(int M, int N, int lda, int ldb, int G_, int c_) { nM = M / BM; nN = N / BM; nwg = nM * nN; G = G_; c = c_; astep = (size_t)BM * lda * 2; bstep = (size_t)BM * ldb * 2; }
    __device__ bool next(int i, Unit& u) const {
        const long L = (long)i * G + c; if (L >= nwg) return false;
        int wgid = (int)L; { const int q = nwg / NXCD, r = nwg % NXCD, xcd = wgid % NXCD, off = wgid / NXCD; wgid = (xcd < r ? xcd * (q + 1) : r * (q + 1) + (xcd - r) * q) + off; }
        const int nig = WGM * nN, gid = wgid / nig, fm = gid * WGM, gsz = (nM - fm) < WGM ? (nM - fm) : WGM;
        u.pm = fm + ((wgid % nig) % gsz); u.pn = (wgid % nig) / gsz; u.aux = 0; u.pad = 0; u.aoff = (size_t)u.pm * astep; u.boff = (size_t)u.pn * bstep; return true;
    }
};
struct OrderS1 {
    int G, c;
    __device__ bool next(int i, Unit& u) const {
        const long L = (long)i * G + c; if (L >= 96) return false;
        u.pm = (int)L / 12; u.pn = (int)L % 12; u.aux = 0; u.pad = 0;
        u.aoff = ((size_t)u.pm * 256 * UROW + (size_t)u.pn * 1280) * 2; u.boff = (size_t)u.pn * 256 * 1280 * 2; return true;
    }
};
struct OrderS2 {
    int G, c;
    __device__ bool next(int i, Unit& u) const {
        const long L = (long)i * G + c; if (L >= 384) return false;
        const int g = (int)L / 16, rem = (int)L % 16; u.pm = rem >> 1; u.pn = rem & 1; u.aux = g; u.pad = 0;
        u.aoff = ((size_t)u.pm * 256 * UROW + (size_t)g * 640) * 2; u.boff = ((size_t)g * 512 + (size_t)u.pn * 256) * 640 * 2; return true;
    }
};

template <class Epi, class Sched>
__device__ __forceinline__ void gemm_phase(LAS unsigned char* lds, const Gemm g, const Sched& S, const Epi& E) {
    const int tid = threadIdx.x, wid = __builtin_amdgcn_readfirstlane(tid >> 6), lane = tid & 63, wr = wid >> 2, wc = wid & 3, fr = lane & 15, fq = lane >> 4;
    const int K = g.K, nt = K / BK;
    unsigned voffA[2], voffB[2];
#pragma unroll
    for (int i = 0; i < 2; ++i) { int R, C; stage_rc(tid * 16 + i * 8192, R, C); const int Rb = Epi::PERM ? ((R & ~31) + perm32(R & 31)) : R;
        voffA[i] = (unsigned)(R * g.lda + C) * 2u; voffB[i] = (unsigned)(Rb * g.ldb + C) * 2u; }
    const size_t kstep = (size_t)(BK * 2);
    const size_t hstepA = (size_t)HALF * g.lda * 2, hstepB = (size_t)HALF * g.ldb * 2;
    const unsigned ldsw = (unsigned)wid * 1024u;
    const int aoff = lds_byte(wr * 64 + fr, fq * 8), boff = lds_byte(wc * 32 + fr, fq * 8);
#define PG8_SA(b, h) (((b) * 2 + (h)) * HTB)
#define PG8_SB(b, h) ((4 + (b) * 2 + (h)) * HTB)
#define PG8_STAGE(bufoff, gbase, voff) do { _Pragma("unroll") for (int _i = 0; _i < 2; ++_i) \
        __builtin_amdgcn_global_load_lds((const unsigned*)((const char*)(gbase) + (voff)[_i]), (LAS unsigned*)(lds + (bufoff) + ldsw + _i * 8192), 16, 0, 0); } while (0)
#define PG8_LDA(dst, b, h) do { _Pragma("unroll") for (int m = 0; m < 4; ++m) _Pragma("unroll") for (int k = 0; k < 2; ++k) dst[m][k] = *(const LAS bf16x8*)(lds + PG8_SA(b, h) + aoff + m * 2048 + k * 1024); } while (0)
#define PG8_LDB(dst, b, h) do { _Pragma("unroll") for (int n = 0; n < 2; ++n) _Pragma("unroll") for (int k = 0; k < 2; ++k) dst[n][k] = *(const LAS bf16x8*)(lds + PG8_SB(b, h) + boff + n * 2048 + k * 1024); } while (0)
#define PG8_MMA(ai, bj, At, Bt) do { __builtin_amdgcn_s_setprio(1); _Pragma("unroll") for (int m = 0; m < 4; ++m) _Pragma("unroll") for (int n = 0; n < 2; ++n) _Pragma("unroll") for (int k = 0; k < 2; ++k) \
        acc[ai][bj][m][n] = __builtin_amdgcn_mfma_f32_16x16x32_bf16(Bt[n][k], At[m][k], acc[ai][bj][m][n], 0, 0, 0); __builtin_amdgcn_s_setprio(0); } while (0)
#define PG8_WAIT_V(n) asm volatile("s_waitcnt vmcnt(" #n ")" ::: "memory")
#define PG8_WAIT_L(n) asm volatile("s_waitcnt lgkmcnt(" #n ")" ::: "memory")
#define PG8_BAR __builtin_amdgcn_s_barrier()
#define PG8_SCHED __builtin_amdgcn_sched_barrier(0)
    Unit cur, nxt; int ui = 0;
    if (!S.next(0, cur)) return;
    f32x4 acc[2][2][4][2];
#pragma unroll
    for (int a = 0; a < 2; ++a)
#pragma unroll
        for (int b = 0; b < 2; ++b)
#pragma unroll
            for (int m = 0; m < 4; ++m)
#pragma unroll
                for (int n = 0; n < 2; ++n) acc[a][b][m][n] = (f32x4){0.f, 0.f, 0.f, 0.f};
    bf16x8 At[4][2], B0[2][2], B1[2][2];
    const char* cA = (const char*)g.A + cur.aoff; const char* cB = (const char*)g.Bt + cur.boff;
    PG8_STAGE(PG8_SB(0, 0), cB, voffB); PG8_STAGE(PG8_SB(0, 1), cB + hstepB, voffB); PG8_STAGE(PG8_SA(0, 0), cA, voffA); PG8_STAGE(PG8_SA(0, 1), cA + hstepA, voffA);
    if (wr == 1) PG8_BAR;
    PG8_WAIT_V(2); PG8_BAR;
    PG8_STAGE(PG8_SB(1, 0), cB + kstep, voffB); PG8_STAGE(PG8_SA(1, 0), cA + kstep, voffA); PG8_STAGE(PG8_SB(1, 1), cB + hstepB + kstep, voffB);
    PG8_WAIT_V(6); PG8_BAR;
    for (;;) {
        const bool has_next = S.next(ui + 1, nxt);
        const char* nA = has_next ? (const char*)g.A + nxt.aoff : cA; const char* nB = has_next ? (const char*)g.Bt + nxt.boff : cB;
#pragma unroll 1
        for (int t = 0; t < nt; t += 2) {
            const bool last = (t == nt - 2);
            const char* a1 = cA + (size_t)(t + 1) * kstep;
            const char* a2 = last ? nA : cA + (size_t)(t + 2) * kstep; const char* b2 = last ? nB : cB + (size_t)(t + 2) * kstep;
            const char* a3 = a2 + kstep; const char* b3 = b2 + kstep;
            PG8_LDB(B0, 0, 0); PG8_LDB(B1, 0, 1); PG8_SCHED; PG8_LDA(At, 0, 0); PG8_STAGE(PG8_SA(1, 1), a1 + hstepA, voffA);
            PG8_WAIT_V(8); PG8_WAIT_L(0); PG8_BAR; PG8_MMA(0, 0, At, B0); PG8_MMA(0, 1, At, B1); PG8_BAR; PG8_SCHED;
            PG8_LDA(At, 0, 1); PG8_STAGE(PG8_SB(0, 0), b2, voffB); PG8_STAGE(PG8_SB(0, 1), b2 + hstepB, voffB); PG8_STAGE(PG8_SA(0, 0), a2, voffA);
            PG8_WAIT_V(8); PG8_WAIT_L(0); PG8_BAR; PG8_MMA(1, 0, At, B0); PG8_MMA(1, 1, At, B1); PG8_BAR; PG8_SCHED;
            PG8_LDB(B0, 1, 0); PG8_LDB(B1, 1, 1); PG8_SCHED; PG8_LDA(At, 1, 0); PG8_STAGE(PG8_SA(0, 1), a2 + hstepA, voffA);
            PG8_WAIT_V(8); PG8_WAIT_L(0); PG8_BAR; PG8_MMA(0, 0, At, B0); PG8_MMA(0, 1, At, B1); PG8_BAR; PG8_SCHED;
            PG8_LDA(At, 1, 1); PG8_STAGE(PG8_SB(1, 0), b3, voffB); PG8_STAGE(PG8_SB(1, 1), b3 + hstepB, voffB); PG8_STAGE(PG8_SA(1, 0), a3, voffA);
            PG8_WAIT_V(8); PG8_WAIT_L(0); PG8_BAR; PG8_MMA(1, 0, At, B0); PG8_MMA(1, 1, At, B1); PG8_BAR; PG8_SCHED;
        }
        if (wr == 0) PG8_BAR;
        E(acc, cur, wr, wc, fr, fq);
        if (!has_next) break;
#pragma unroll
        for (int a = 0; a < 2; ++a)
#pragma unroll
            for (int b = 0; b < 2; ++b)
#pragma unroll
                for (int m = 0; m < 4; ++m)
#pragma unroll
                    for (int n = 0; n < 2; ++n) acc[a][b][m][n] = (f32x4){0.f, 0.f, 0.f, 0.f};
        cur = nxt; cA = nA; cB = nB; ++ui;
        if (wr == 1) PG8_BAR;
    }
    PG8_WAIT_V(0);
    PG8_BAR;
#undef PG8_SA
#undef PG8_SB
#undef PG8_STAGE
#undef PG8_LDA
#undef PG8_LDB
#undef PG8_MMA
#undef PG8_WAIT_V
#undef PG8_WAIT_L
#undef PG8_BAR
#undef PG8_SCHED
}

typedef f32x4 Acc[2][2][4][2];
__device__ __forceinline__ u32x4 pack8(f32x4 v0, f32x4 v1) { u32x4 w; w.x = cvt_pk_bf16(v0[0], v0[1]); w.y = cvt_pk_bf16(v0[2], v0[3]); w.z = cvt_pk_bf16(v1[0], v1[1]); w.w = cvt_pk_bf16(v1[2], v1[3]); return w; }

struct EpiIn {
    static constexpr bool PERM = true;
    bf16_t* PROJ; bf16_t* UBUF;
    __device__ __forceinline__ void operator()(const Acc& acc, const Unit& u, int wr, int wc, int fr, int fq) const {
#pragma unroll
        for (int bj = 0; bj < 2; ++bj) {
            const int blk = 2 * u.pn + bj, col0 = 128 * blk + 32 * wc + 8 * fq;
#pragma unroll
            for (int ai = 0; ai < 2; ++ai)
#pragma unroll
                for (int m = 0; m < 4; ++m) {
                    const int row = u.pm * BM + ai * HALF + wr * 64 + m * 16 + fr;
                    f32x4 v0 = acc[ai][bj][m][0], v1 = acc[ai][bj][m][1];
                    if (blk >= 8) {
#pragma unroll
                        for (int j = 0; j < 4; ++j) { v0[j] = silu_f(v0[j]); v1[j] = silu_f(v1[j]); }
                    } else if (blk >= 6) { v0 = v0 * 0.18033688f; v1 = v1 * 0.18033688f; }
                    const u32x4 w = pack8(v0, v1);
                    if (blk >= 3 && blk < 6) { const int cc = col0 - 384, gg = cc >> 4, cin = cc & 15;
                        *(u32x4*)(UBUF + (size_t)(row >> 5) * UROW + gg * 640 + (row & 31) * 16 + cin) = w; }
                    else *(u32x4*)(PROJ + (size_t)row * INW + col0) = w;
                }
        }
    }
};
struct EpiS1 {
    static constexpr bool PERM = false;
    float* SEND;
    __device__ __forceinline__ void operator()(const Acc& acc, const Unit& u, int wr, int wc, int fr, int fq) const {
        const int row0 = u.pm * BM + wr * 64 + fr, col0 = u.pn * BM + wc * 32 + 4 * fq;
#pragma unroll
        for (int ai = 0; ai < 2; ++ai)
#pragma unroll
            for (int m = 0; m < 4; ++m) { float* rowp = SEND + (size_t)(row0 + ai * HALF + m * 16) * 3072 + col0;
#pragma unroll
                for (int bj = 0; bj < 2; ++bj)
#pragma unroll
                    for (int n = 0; n < 2; ++n) *(f32x4*)(rowp + bj * HALF + n * 16) = acc[ai][bj][m][n]; }
    }
};
struct EpiKV {
    static constexpr bool PERM = true;
    bf16_t* KB; bf16_t* VT;
    __device__ __forceinline__ void operator()(const Acc& acc, const Unit& u, int wr, int wc, int fr, int fq) const {
#pragma unroll
        for (int bj = 0; bj < 2; ++bj) {
            const int c0 = 128 * bj + 32 * wc + 8 * fq, hh = c0 >> 6, d0 = c0 & 63;
#pragma unroll
            for (int ai = 0; ai < 2; ++ai)
#pragma unroll
                for (int m = 0; m < 4; ++m) {
                    const int row = u.pm * BM + ai * HALF + wr * 64 + m * 16 + fr, b = row >> 8, mm = row & 255;
                    const f32x4 v0 = acc[ai][bj][m][0], v1 = acc[ai][bj][m][1];
                    if (u.pn == 0) *(u32x4*)(KB + ((size_t)(b * NH + hh) * NMEM + mm) * HD + d0) = pack8(v0, v1);
                    else { bf16_t* p = VT + ((size_t)(b * NH + hh) * HD + d0) * NMEM + mm;
#pragma unroll
                        for (int j = 0; j < 4; ++j) { p[j * NMEM] = f2bf(v0[j]); p[(4 + j) * NMEM] = f2bf(v1[j]); } }
                }
        }
    }
};
struct EpiS2 {
    static constexpr bool PERM = true;
    bf16_t* YB;
    __device__ __forceinline__ void operator()(const Acc& acc, const Unit& u, int wr, int wc, int fr, int fq) const {
#pragma unroll
        for (int bj = 0; bj < 2; ++bj) {
            const int j0 = u.pn * BM + 128 * bj + 32 * wc + 8 * fq, t = j0 >> 4, cp = j0 & 15;
#pragma unroll
            for (int ai = 0; ai < 2; ++ai)
#pragma unroll
                for (int m = 0; m < 4; ++m) {
                    const int row = u.pm * BM + ai * HALF + wr * 64 + m * 16 + fr;
                    f32x4 v0 = acc[ai][bj][m][0], v1 = acc[ai][bj][m][1];
#pragma unroll
                    for (int j = 0; j < 4; ++j) { v0[j] = gelu_tanh_f(v0[j]); v1[j] = gelu_tanh_f(v1[j]); }
                    *(u32x4*)(YB + ((size_t)row * CT + t) * SSMW + u.aux * SG + cp) = pack8(v0, v1);
                }
        }
    }
};
struct EpiGlu {
    static constexpr bool PERM = true;
    const bf16_t* PROJ; bf16_t* GB;
    __device__ __forceinline__ void operator()(const Acc& acc, const Unit& u, int wr, int wc, int fr, int fq) const {
        const int jj0 = (u.pn * BM + 32 * wc + 8 * fq) >> 1;
        const unsigned row0 = (unsigned)(u.pm * BM + wr * 64 + fr);
        const unsigned goff0 = (row0 * INW + 1024 + 384 + jj0) * 2u, ooff0 = (row0 * DM + 384 + jj0) * 2u;
#pragma unroll
        for (int ai = 0; ai < 2; ++ai)
#pragma unroll
            for (int m = 0; m < 4; ++m) {
                const unsigned goff = goff0 + (unsigned)(ai * HALF + m * 16) * INW * 2u, ooff = ooff0 + (unsigned)(ai * HALF + m * 16) * DM * 2u;
#pragma unroll
                for (int bj = 0; bj < 2; ++bj) {
                    const f32x4 z1 = acc[ai][bj][m][0], z2 = acc[ai][bj][m][1];
                    const u32x2 sg = *(const u32x2*)((const char*)PROJ + (goff + 128u * bj));
                    const float o0 = z1[0] * sigmoid_f(z2[0]) * bf_lo(sg.x), o1 = z1[1] * sigmoid_f(z2[1]) * bf_hi(sg.x);
                    const float o2 = z1[2] * sigmoid_f(z2[2]) * bf_lo(sg.y), o3 = z1[3] * sigmoid_f(z2[3]) * bf_hi(sg.y);
                    u32x2 w; w.x = cvt_pk_bf16(o0, o1); w.y = cvt_pk_bf16(o2, o3);
                    *(u32x2*)((char*)GB + (ooff + 128u * bj)) = w;
                }
                asm volatile("" ::: "memory");
            }
    }
};
struct EpiOut {
    static constexpr bool PERM = true;
    bf16_t* OB; float* SSQ;
    __device__ __forceinline__ void operator()(const Acc& acc, const Unit& u, int wr, int wc, int fr, int fq) const {
#pragma unroll
        for (int ai = 0; ai < 2; ++ai)
#pragma unroll
            for (int m = 0; m < 4; ++m) {
                const int row = u.pm * BM + ai * HALF + wr * 64 + m * 16 + fr;
                float s = 0.f;
#pragma unroll
                for (int bj = 0; bj < 2; ++bj) {
                    const int col0 = u.pn * BM + 128 * bj + 32 * wc + 8 * fq;
                    const f32x4 v0 = acc[ai][bj][m][0], v1 = acc[ai][bj][m][1];
                    s += (v0[0] * v0[0] + v0[1] * v0[1]) + (v0[2] * v0[2] + v0[3] * v0[3]) + (v1[0] * v1[0] + v1[1] * v1[1]) + (v1[2] * v1[2] + v1[3] * v1[3]);
                    *(u32x4*)(OB + (size_t)row * DM + col0) = pack8(v0, v1);
                }
                s += __shfl_xor(s, 16); s += __shfl_xor(s, 32);
                if (fq == 0) SSQ[(size_t)row * 16 + u.pn * 4 + wc] = s;
            }
    }
};
}


#define XB_TMO      128
#define XB_XCNT(j)  (256  + 64 * (j))
#define XB_XSUB(j)  (1280 + 64 * (j))
#define XB_XGEN(j)  (2304 + 64 * (j))
#define XB_TOP      3328
#define XB_TOPGEN   3392
#define XCD_BAR_WORDS 3456
#define XB_SPIN_CAP (1u << 18)
__device__ __forceinline__ unsigned xb_ld(unsigned* p)              { return __hip_atomic_load(p, __ATOMIC_RELAXED, __HIP_MEMORY_SCOPE_AGENT); }
__device__ __forceinline__ unsigned xb_add(unsigned* p, unsigned v) { return __hip_atomic_fetch_add(p, v, __ATOMIC_RELAXED, __HIP_MEMORY_SCOPE_AGENT); }
__device__ __forceinline__ unsigned xb_xcc_id() { return (unsigned)__builtin_amdgcn_s_getreg((3 << 11) | 20) & 0xFu; }
#define XB_SPIN(cond, bar) do { unsigned _sp = 0; while (cond) { __builtin_amdgcn_s_sleep(1); \
    if ((++_sp & 255u) == 0u) { if (xb_ld(&(bar)[XB_TMO])) break; if (_sp > XB_SPIN_CAP) { atomicAdd(&(bar)[XB_TMO], 1u); break; } } } } while (0)
struct XcdBarrier { unsigned* bar; unsigned x; volatile LAS unsigned* st; };
__device__ __forceinline__ XcdBarrier xcd_barrier_post(unsigned* bar, volatile LAS unsigned* st) {
    XcdBarrier b; b.bar = bar; b.x = xb_xcc_id(); b.st = st;
    if (threadIdx.x == 0) (void)xb_add(&bar[XB_XCNT(b.x)], 1u);
    return b;
}
__device__ __forceinline__ void xcd_barrier_complete(unsigned* bar, unsigned x, unsigned& nloc, unsigned& nx) {
    const unsigned G = gridDim.x * gridDim.y * gridDim.z;
    unsigned sum, cnt, mine, sp = 0u;
    for (;;) {
        sum = 0u; cnt = 0u; mine = 0u;
#pragma unroll
        for (unsigned j = 0; j < 16; ++j) { const unsigned c = xb_ld(&bar[XB_XCNT(j)]); sum += c; cnt += (c > 0u) ? 1u : 0u; mine = (j == x) ? c : mine; }
        if (sum == G) break;
        __builtin_amdgcn_s_sleep(1);
        if ((++sp & 255u) == 0u) { if (xb_ld(&bar[XB_TMO])) break; if (sp > XB_SPIN_CAP) { atomicAdd(&bar[XB_TMO], 1u); break; } }
    }
    nloc = mine > 0u ? mine : 1u; nx = cnt > 0u ? cnt : 1u;
}
__device__ __forceinline__ void xcd_barrier(const XcdBarrier& b) {
    asm volatile("s_waitcnt vmcnt(0)" ::: "memory");
    __syncthreads();
    if (threadIdx.x == 0) {
        unsigned* bar = b.bar;
        __builtin_amdgcn_s_waitcnt(0);
        unsigned nloc = b.st[0], nx = b.st[1];
        if (nloc == 0u) { xcd_barrier_complete(bar, b.x, nloc, nx); b.st[0] = nloc; b.st[1] = nx; }
        const unsigned old = xb_add(&bar[XB_XSUB(b.x)], 1u);
        const unsigned gen = old / nloc;
        if (old + 1u == (gen + 1u) * nloc) {
            __builtin_amdgcn_fence(__ATOMIC_RELEASE, "agent");
            asm volatile("s_waitcnt vmcnt(0)" ::: "memory");
            const unsigned og = xb_add(&bar[XB_TOP], 1u);
            const unsigned tg = og / nx;
            if (og + 1u == (tg + 1u) * nx) xb_add(&bar[XB_TOPGEN], 1u);
            else XB_SPIN(xb_ld(&bar[XB_TOPGEN]) == tg, bar);
            __builtin_amdgcn_fence(__ATOMIC_ACQUIRE, "agent");
            xb_add(&bar[XB_XGEN(b.x)], 1u);
            asm volatile("s_waitcnt vmcnt(0)" ::: "memory");
        } else {
            XB_SPIN(xb_ld(&bar[XB_XGEN(b.x)]) == gen, bar);
            __builtin_amdgcn_fence(__ATOMIC_ACQUIRE, "agent");
            asm volatile("s_waitcnt vmcnt(0)" ::: "memory");
        }
    }
    __syncthreads();
}

struct Args {
    const float* x; const float* mem; const float* g_pre; const float* w_in; const float* w_pool; const float* pool_scale;
    const float* a_re; const float* a_im; const float* log_dt; const float* b_re; const float* b_im; const float* c_re; const float* c_im;
    const float* d_skip; const float* w_glu; const float* g_mem; const float* w_kv; const float* w_out; const float* g_post;
    float* out; unsigned char* ws; int ph_lo, ph_hi;
};

__device__ __forceinline__ float wave_sum(float v) {
    v += __shfl_xor(v, 32); v += __shfl_xor(v, 16); v += __shfl_xor(v, 8); v += __shfl_xor(v, 4); v += __shfl_xor(v, 2); v += __shfl_xor(v, 1); return v;
}

__device__ __forceinline__ void rmsnorm_rows(const float* src, const float* g, bf16_t* dst, int nrows, int gwave, int nwaves, int lane) {
    for (int row = gwave; row < nrows; row += nwaves) {
        const f32x4* p = (const f32x4*)(src + (size_t)row * DM);
        f32x4 v[4]; float ss = 0.f;
#pragma unroll
        for (int i = 0; i < 4; ++i) { v[i] = p[lane + 64 * i]; ss += (v[i][0] * v[i][0] + v[i][1] * v[i][1]) + (v[i][2] * v[i][2] + v[i][3] * v[i][3]); }
        ss = wave_sum(ss);
        const float rs = rsqrtf(ss * (1.0f / DM) + EPS);
#pragma unroll
        for (int i = 0; i < 4; ++i) { const f32x4 gv = ((const f32x4*)g)[lane + 64 * i];
            u32x2 w; w.x = cvt_pk_bf16(v[i][0] * rs * gv[0], v[i][1] * rs * gv[1]); w.y = cvt_pk_bf16(v[i][2] * rs * gv[2], v[i][3] * rs * gv[3]);
            *(u32x2*)(dst + (size_t)row * DM + 4 * (lane + 64 * i)) = w; }
    }
}

template <int MODE>
__device__ __forceinline__ void tr_tile(const float* src, int ld_src, int k0, int n0, bf16_t* dst, int ld_dst, LAS float* tile, int tid) {
    __syncthreads();
    for (int e = tid; e < 4096; e += 512) { const int kk = e >> 6, nn = e & 63; tile[kk * 65 + nn] = src[(size_t)(k0 + kk) * ld_src + n0 + nn]; }
    __syncthreads();
    for (int e = tid; e < 4096; e += 512) { const int nn = e >> 6, kk = e & 63; int n = n0 + nn;
        if (MODE == 1) { n = (n < 384) ? (8 * (n >> 2) + (n & 3)) : (8 * ((n - 384) >> 2) + 4 + ((n - 384) & 3)); }
        dst[(size_t)n * ld_dst + k0 + kk] = f2bf(tile[kk * 65 + nn]); }
}

__global__ void __launch_bounds__(512, 2) mega(Args a) {
    extern __shared__ __attribute__((aligned(16))) unsigned char lds_raw[];
    LAS unsigned char* lds = (LAS unsigned char*)lds_raw;
    const int G = gridDim.x, bid = blockIdx.x;
#define TIDS int tid = threadIdx.x; asm volatile("" : "+v"(tid)); const int lane = tid & 63, wave = tid >> 6; (void)lane; (void)wave
#define WSP unsigned char* ws = a.ws; asm volatile("" : "+s"(ws))
#define HB ((bf16_t*)(ws + WS_HB))
#define GBUF ((bf16_t*)(ws + WS_HB))
#define PROJ ((bf16_t*)(ws + WS_PROJ))
#define OBUF ((bf16_t*)(ws + WS_PROJ))
#define UBUF ((bf16_t*)(ws + WS_UBUF))
#define SEND ((float*)(ws + WS_SEND))
#define YBUF ((bf16_t*)(ws + WS_YBUF))
#define SSQ ((float*)(ws + WS_SSQ))
#define MBF ((bf16_t*)(ws + WS_MB))
#define KB ((bf16_t*)(ws + WS_KB))
#define VT ((bf16_t*)(ws + WS_VT))
#define WIN ((bf16_t*)(ws + WS_WIN))
#define WKV ((bf16_t*)(ws + WS_WKV))
#define WGLU ((bf16_t*)(ws + WS_WGLU))
#define WOUT ((bf16_t*)(ws + WS_WOUT))
#define BS1 ((bf16_t*)(ws + WS_BS1))
#define BS2 ((bf16_t*)(ws + WS_BS2))
#define LAMT ((float*)(ws + WS_LAMT))
    const int lo = a.ph_lo, hi = a.ph_hi;
    if (threadIdx.x < 4) ((LAS unsigned*)(lds + 131072))[threadIdx.x] = 0u;
    __syncthreads();
    XcdBarrier gbar; gbar.bar = (unsigned*)(a.ws + WS_CTL); gbar.x = 0; gbar.st = (volatile LAS unsigned*)(lds + 131072);
    if (hi - lo > 1) gbar = xcd_barrier_post((unsigned*)(a.ws + WS_CTL), (volatile LAS unsigned*)(lds + 131072));
    if (hi > 8) cg::this_grid().sync();
#ifndef PH_MASK
#define PH_MASK 0xff
#endif
#ifndef PROBE_MASK
#define PROBE_MASK 0
#endif
#define IN(k) (((PH_MASK >> (k)) & 1) && lo <= (k) && (k) < hi)
#define REPS(k) for (int rep_ = 0; rep_ < (((PROBE_MASK >> (k)) & 1) ? 2 : 1); ++rep_)
#define SEAM(k) do { if (IN(k) && IN((k) + 1)) { xcd_barrier(gbar); } } while (0)

    if (IN(0)) REPS(0) {
        WSP;
        TIDS;
        LAS float* sm = (LAS float*)lds;
        constexpr int N_SSM = NG * CT, N_TRIN = 26 * 16, N_TROUT = 256, N_TRGLU = 72, N_TRKV = 128, N_FOLD = 64;
        constexpr int I1 = N_SSM, I2 = I1 + N_TRIN, I3 = I2 + N_TROUT, I4 = I3 + N_TRGLU, I5 = I4 + N_TRKV, I6 = I5 + N_FOLD;
        for (int item = bid; item < I6; item += G) {
            if (item < I1) {
                const int g = item / CT, j = item % CT;
                __syncthreads();
                if (tid < 64) {
                    const int n = tid; const float ar = a.a_re[g * SN + n], ai = a.a_im[g * SN + n], dt = expf(a.log_dt[g]);
                    const float xr = ar * dt, yi = ai * dt;
                    float s0, c0, s1, c1, sy, cy;
                    const float m0 = expf((float)j * xr); sincosf((float)j * yi, &s0, &c0);
                    const float m1 = expf((float)(j + 1) * xr); sincosf((float)(j + 1) * yi, &s1, &c1);
                    const float e1 = expm1f(xr); sincosf(yi, &sy, &cy); const float sh = sinf(0.5f * yi);
                    const float br = e1 * cy - 2.f * sh * sh, bi = (e1 + 1.f) * sy;
                    const float den = 1.f / (ar * ar + ai * ai);
                    const float cr = (br * ar + bi * ai) * den, ci = (bi * ar - br * ai) * den;
                    const float ljr = m0 * c0, lji = m0 * s0;
                    sm[n] = ljr; sm[64 + n] = lji; sm[128 + n] = m1 * c1; sm[192 + n] = m1 * s1;
                    sm[256 + n] = ljr * cr - lji * ci; sm[320 + n] = ljr * ci + lji * cr;
                    if (j == CT - 1) { LAMT[(g * SN + n) * 2] = m1 * c1; LAMT[(g * SN + n) * 2 + 1] = m1 * s1; }
                }
                __syncthreads();
                bf16_t* bs2 = BS2 + (size_t)g * 512 * 640;
                if (tid < 256) {
                    const int cp = tid >> 4, c = tid & 15; float kv = 0.f;
                    for (int n = 0; n < SN; ++n) {
                        const float Br = a.b_re[((size_t)g * SN + n) * SG + c], Bi = a.b_im[((size_t)g * SN + n) * SG + c];
                        const float Cr = a.c_re[((size_t)g * SG + cp) * SN + n], Ci = a.c_im[((size_t)g * SG + cp) * SN + n];
                        const float lr = sm[256 + n], li = sm[320 + n];
                        const float pr = lr * Br - li * Bi, pi = lr * Bi + li * Br;
                        kv += Cr * pr - Ci * pi;
                    }
                    if (j == 0 && c == cp) kv += a.d_skip[g * SG + cp];
                    const bf16_t kb = f2bf(kv);
                    for (int t = j; t < CT; ++t) { const int s = t - j;
                        bs2[(size_t)(t * SG + cp) * 640 + s * SG + c] = kb;
                        if (j > 0) bs2[(size_t)(s * SG + cp) * 640 + t * SG + c] = 0; }
                } else {
#pragma unroll
                    for (int r = 0; r < 4; ++r) { const int idx = (tid - 256) + 256 * r, cp = idx >> 6, n = idx & 63;
                        const float Cr = a.c_re[((size_t)g * SG + cp) * SN + n], Ci = a.c_im[((size_t)g * SG + cp) * SN + n];
                        const float lr = sm[128 + n], li = sm[192 + n];
                        bs2[(size_t)(j * SG + cp) * 640 + 512 + n] = f2bf(Cr * lr - Ci * li);
                        bs2[(size_t)(j * SG + cp) * 640 + 576 + n] = f2bf(-(Cr * li + Ci * lr)); }
                }
                {
                    const int s = CT - 1 - j, p = g >> 1, gl = g & 1;
                    bf16_t* bs1 = BS1 + (size_t)p * 256 * 1280;
#pragma unroll
                    for (int r = 0; r < 2; ++r) { const int idx = tid + 512 * r, n = idx >> 4, c = idx & 15;
                        const float Br = a.b_re[((size_t)g * SN + n) * SG + c], Bi = a.b_im[((size_t)g * SN + n) * SG + c];
                        const float lr = sm[256 + n], li = sm[320 + n];
                        bs1[(size_t)(gl * 128 + n) * 1280 + gl * 640 + s * SG + c] = f2bf(lr * Br - li * Bi);
                        bs1[(size_t)(gl * 128 + 64 + n) * 1280 + gl * 640 + s * SG + c] = f2bf(lr * Bi + li * Br); }
                    for (int idx = tid; idx < 128 * 24; idx += 512) { const int rr = idx / 24, q = idx % 24; int col;
                        if (q < 16) col = (1 - gl) * 640 + s * SG + q; else if (q < 20) col = gl * 640 + 512 + 4 * s + (q - 16); else col = (1 - gl) * 640 + 512 + 4 * s + (q - 20);
                        bs1[(size_t)(gl * 128 + rr) * 1280 + col] = 0; }
                }
            } else if (item < I2) { const int it = item - I1, ntl = it / 16, kt = it % 16; tr_tile<0>(a.w_in, INW, 64 * kt, 384 + 64 * ntl, WIN, DM, sm, tid); }
            else if (item < I3) { const int it = item - I2, ntl = it / 16, kt = it % 16; tr_tile<0>(a.w_out, DM, 64 * kt, 64 * ntl, WOUT, DM, sm, tid); }
            else if (item < I4) { const int it = item - I3, ntl = it / 6, kt = it % 6; tr_tile<1>(a.w_glu, 768, 64 * kt, 64 * ntl, WGLU, 384, sm, tid); }
            else if (item < I5) { const int it = item - I4, ntl = it / 16, kt = it % 16; tr_tile<0>(a.w_kv, 512, 64 * kt, 64 * ntl, WKV, DM, sm, tid); }
            else {
                const int it = item - I5, kt = it >> 2, gi = it & 3, k0 = 64 * kt;
                LAS float* At = sm; LAS float* Wp = sm + 64 * 97;
                __syncthreads();
                for (int e = tid; e < 64 * 96; e += 512) { const int kk = e / 96, c = e % 96; At[kk * 97 + c] = a.w_in[(size_t)(k0 + kk) * INW + gi * 96 + c]; }
                for (int e = tid; e < 96 * 96; e += 512) Wp[e] = a.w_pool[(size_t)gi * 9216 + e];
                __syncthreads();
                const int kk = tid & 63, d0 = (tid >> 6) * 12;
                float ac[12];
#pragma unroll
                for (int i = 0; i < 12; ++i) ac[i] = 0.f;
                for (int c = 0; c < 96; ++c) { const float av = At[kk * 97 + c];
#pragma unroll
                    for (int i = 0; i < 12; ++i) ac[i] += av * Wp[c * 96 + d0 + i]; }
#pragma unroll
                for (int i = 0; i < 12; ++i) { const int d = gi * 96 + d0 + i; WIN[(size_t)d * DM + k0 + kk] = f2bf(ac[i] * a.pool_scale[d]); }
            }
        }
        for (int idx = bid * 512 + tid; idx < NRC * NG * 16; idx += G * 512) { const int row = idx / (NG * 16), rem = idx % (NG * 16), g = rem >> 4, q = rem & 15;
            *(u32x4*)(UBUF + (size_t)row * UROW + g * 640 + 512 + q * 8) = (u32x4){0u, 0u, 0u, 0u}; }
        rmsnorm_rows(a.mem, a.g_mem, MBF, NB * NMEM, bid * 8 + wave, G * 8, lane);
        rmsnorm_rows(a.x, a.g_pre, HB, NTOK, bid * 8 + wave, G * 8, lane);
    }
    SEAM(0);

    if (IN(1)) REPS(1) {
        WSP;
        pg8::Gemm g{HB, WIN, DM, DM, DM}; pg8::OrderStd S; S.init(NTOK, INW, DM, DM, G, bid);
        pg8::EpiIn E{PROJ, UBUF};
        pg8::gemm_phase<pg8::EpiIn, pg8::OrderStd>(lds, g, S, E);
    }
    SEAM(1);

    if (IN(2)) REPS(2) {
        WSP;
        { pg8::Gemm g{UBUF, BS1, UROW, 1280, 1280}; pg8::OrderS1 S{G, bid}; pg8::EpiS1 E{SEND};
          pg8::gemm_phase<pg8::EpiS1, pg8::OrderS1>(lds, g, S, E); }
        { pg8::Gemm g{MBF, WKV, DM, DM, DM}; pg8::OrderStd S; S.init(NB * NMEM, 512, DM, DM, G, (bid + 160) % G); pg8::EpiKV E{KB, VT};
          pg8::gemm_phase<pg8::EpiKV, pg8::OrderStd>(lds, g, S, E); }
    }
    SEAM(2);

    if (IN(3)) REPS(3) {
        WSP;
        TIDS;
        for (int idx = bid * 512 + tid; idx < NB * NG * SN; idx += G * 512) {
            const int b = idx / (NG * SN), rem = idx % (NG * SN), g = rem >> 6, n = rem & 63;
            const float lr = LAMT[(g * SN + n) * 2], li = LAMT[(g * SN + n) * 2 + 1];
            float hr = 0.f, hi2 = 0.f;
            for (int k = 0; k < NCH; ++k) {
                const size_t row = (size_t)b * NCH + k;
                UBUF[row * UROW + g * 640 + 512 + n] = f2bf(hr); UBUF[row * UROW + g * 640 + 576 + n] = f2bf(hi2);
                const float sr = SEND[row * 3072 + g * 128 + n], si = SEND[row * 3072 + g * 128 + 64 + n];
                const float nr = lr * hr - li * hi2 + sr, ni = lr * hi2 + li * hr + si; hr = nr; hi2 = ni;
            }
        }
    }
    SEAM(3);

    if (IN(4)) REPS(4) {
        WSP;
        { pg8::Gemm g{UBUF, BS2, UROW, 640, 640}; pg8::OrderS2 S{G, bid}; pg8::EpiS2 E{YBUF};
          pg8::gemm_phase<pg8::EpiS2, pg8::OrderS2>(lds, g, S, E); }
        TIDS;
        for (int it = bid * 512 + tid; it < (NTOK / 16) * 48; it += G * 512) {
            const int run = it / 48, cgp = it % 48, b = run >> 7, t0 = (run & 127) * 16, gi = cgp / 12, w = 2 << gi;
            const bf16_t* zb = PROJ + (size_t)b * SEQ * INW + 8 * cgp;
            float S[8];
#pragma unroll
            for (int k = 0; k < 8; ++k) S[k] = 0.f;
            for (int i = 1; i < w; ++i) { const int tt = t0 - i; if (tt >= 0) { const u32x4 v = *(const u32x4*)(zb + (size_t)tt * INW);
                S[0] += bf_lo(v.x); S[1] += bf_hi(v.x); S[2] += bf_lo(v.y); S[3] += bf_hi(v.y); S[4] += bf_lo(v.z); S[5] += bf_hi(v.z); S[6] += bf_lo(v.w); S[7] += bf_hi(v.w); } }
            for (int dt = 0; dt < 16; ++dt) {
                const int t = t0 + dt; const u32x4 v = *(const u32x4*)(zb + (size_t)t * INW);
                float z[8] = {bf_lo(v.x), bf_hi(v.x), bf_lo(v.y), bf_hi(v.y), bf_lo(v.z), bf_hi(v.z), bf_lo(v.w), bf_hi(v.w)};
                const float inv = 1.0f / (float)((t + 1) < w ? (t + 1) : w);
                const u32x4 gv = *(const u32x4*)(PROJ + ((size_t)b * SEQ + t) * INW + 1024 + 8 * cgp);
                const float sg[8] = {bf_lo(gv.x), bf_hi(gv.x), bf_lo(gv.y), bf_hi(gv.y), bf_lo(gv.z), bf_hi(gv.z), bf_lo(gv.w), bf_hi(gv.w)};
                float o[8];
#pragma unroll
                for (int k = 0; k < 8; ++k) { S[k] += z[k]; o[k] = (S[k] * inv - z[k]) * sg[k]; }
                u32x4 wv; wv.x = cvt_pk_bf16(o[0], o[1]); wv.y = cvt_pk_bf16(o[2], o[3]); wv.z = cvt_pk_bf16(o[4], o[5]); wv.w = cvt_pk_bf16(o[6], o[7]);
                *(u32x4*)(GBUF + ((size_t)b * SEQ + t) * DM + 8 * cgp) = wv;
                const int tr = t - w + 1;
                if (tr >= 0) { const u32x4 r = *(const u32x4*)(zb + (size_t)tr * INW);
                    S[0] -= bf_lo(r.x); S[1] -= bf_hi(r.x); S[2] -= bf_lo(r.y); S[3] -= bf_hi(r.y); S[4] -= bf_lo(r.z); S[5] -= bf_hi(r.z); S[6] -= bf_lo(r.w); S[7] -= bf_hi(r.w); }
            }
        }
    }
    SEAM(4);

    if (IN(5)) REPS(5) {
        WSP;
#ifndef NO_GLU
        { pg8::Gemm g{YBUF, WGLU, SSMW, SSMW, SSMW}; pg8::OrderStd S; S.init(NTOK, 768, SSMW, SSMW, G, bid); pg8::EpiGlu E{PROJ, GBUF};
          pg8::gemm_phase<pg8::EpiGlu, pg8::OrderStd>(lds, g, S, E); }
#endif
#ifndef NO_ATT
        TIDS;
        constexpr int VOFF = 256 * 144;
        const int fr = lane & 15, fq = lane >> 4;
        for (int item = bid; item < NB * 16 * NH; item += G) {
            const int b = item >> 6, rem = item & 63, h = rem & 3, tile = rem >> 2;
            const bf16_t* Kg = KB + (size_t)(b * NH + h) * NMEM * HD; const bf16_t* Vg = VT + (size_t)(b * NH + h) * HD * NMEM;
            __syncthreads();
            for (int e = tid; e < 2048; e += 512) { const int m = e >> 3, dc = e & 7; const u32x4 v = *(const u32x4*)(Kg + m * HD + dc * 8);
                const int slot = (m & ~31) + 16 * ((m >> 2) & 1) + 4 * ((m >> 3) & 3) + (m & 3);
                *(LAS u32x4*)(lds + slot * 144 + dc * 16) = v; }
            for (int e = tid; e < 2048; e += 512) { const int d = e >> 5, mc = e & 31; const u32x4 v = *(const u32x4*)(Vg + d * NMEM + mc * 8);
                *(LAS u32x4*)(lds + VOFF + d * 528 + mc * 16) = v; }
            __syncthreads();
            const size_t token = (size_t)b * SEQ + tile * 128 + wave * 16 + fr;
            bf16x8 qf[2];
#pragma unroll
            for (int kk = 0; kk < 2; ++kk) qf[kk] = *(const bf16x8*)(PROJ + token * INW + 768 + h * HD + 32 * kk + 8 * fq);
            f32x4 s[8][2];
            float mx = -3.0e38f;
#pragma unroll
            for (int blk = 0; blk < 8; ++blk)
#pragma unroll
                for (int sub = 0; sub < 2; ++sub) {
                    f32x4 ac = (f32x4){0.f, 0.f, 0.f, 0.f};
#pragma unroll
                    for (int kk = 0; kk < 2; ++kk) { const bf16x8 af = *(const LAS bf16x8*)(lds + (32 * blk + 16 * sub + fr) * 144 + (32 * kk + 8 * fq) * 2);
                        ac = __builtin_amdgcn_mfma_f32_16x16x32_bf16(af, qf[kk], ac, 0, 0, 0); }
                    s[blk][sub] = ac;
                    mx = fmaxf(mx, fmaxf(fmaxf(ac[0], ac[1]), fmaxf(ac[2], ac[3])));
                }
            mx = fmaxf(mx, __shfl_xor(mx, 16)); mx = fmaxf(mx, __shfl_xor(mx, 32));
            float sum = 0.f; bf16x8 pb[8];
#pragma unroll
            for (int blk = 0; blk < 8; ++blk) {
                f32x4 p0, p1;
#pragma unroll
                for (int j = 0; j < 4; ++j) { p0[j] = __builtin_amdgcn_exp2f(s[blk][0][j] - mx); p1[j] = __builtin_amdgcn_exp2f(s[blk][1][j] - mx); }
                sum += (p0[0] + p0[1]) + (p0[2] + p0[3]) + (p1[0] + p1[1]) + (p1[2] + p1[3]);
                const u32x4 pw = pg8::pack8(p0, p1); pb[blk] = __builtin_bit_cast(bf16x8, pw);
            }
            sum += __shfl_xor(sum, 16); sum += __shfl_xor(sum, 32);
            const float inv = 1.0f / sum;
#pragma unroll
            for (int dt = 0; dt < 4; ++dt) {
                f32x4 o = (f32x4){0.f, 0.f, 0.f, 0.f};
#pragma unroll
                for (int blk = 0; blk < 8; ++blk) { const bf16x8 vf = *(const LAS bf16x8*)(lds + VOFF + (16 * dt + fr) * 528 + (32 * blk + 8 * fq) * 2);
                    o = __builtin_amdgcn_mfma_f32_16x16x32_bf16(vf, pb[blk], o, 0, 0, 0); }
                const int d0 = 16 * dt + 4 * fq;
                const u32x2 sg = *(const u32x2*)(PROJ + token * INW + 1024 + 768 + h * HD + d0);
                u32x2 wv; wv.x = cvt_pk_bf16(o[0] * inv * bf_lo(sg.x), o[1] * inv * bf_hi(sg.x)); wv.y = cvt_pk_bf16(o[2] * inv * bf_lo(sg.y), o[3] * inv * bf_hi(sg.y));
                *(u32x2*)(GBUF + token * DM + 768 + h * HD + d0) = wv;
            }
        }
#endif
    }
    SEAM(5);

    if (IN(6)) REPS(6) {
        WSP;
        pg8::Gemm g{GBUF, WOUT, DM, DM, DM}; pg8::OrderStd S; S.init(NTOK, DM, DM, DM, G, bid); pg8::EpiOut E{OBUF, SSQ};
        pg8::gemm_phase<pg8::EpiOut, pg8::OrderStd>(lds, g, S, E);
    }
    SEAM(6);
#ifdef PROBE_SYNCS
    for (int q_ = 0; q_ < PROBE_SYNCS; ++q_) xcd_barrier(gbar);
#endif

    if (IN(7)) REPS(7) {
        WSP;
        TIDS;
        for (int row = bid * 8 + wave; row < NTOK; row += G * 8) {
            float ss = (lane < 16) ? SSQ[(size_t)row * 16 + lane] : 0.f;
            ss = wave_sum(ss);
            const float rs = rsqrtf(ss * (1.0f / DM) + EPS);
#pragma unroll
            for (int i = 0; i < 4; ++i) { const int c = 4 * (lane + 64 * i);
                const u32x2 ov = *(const u32x2*)(OBUF + (size_t)row * DM + c);
                const f32x4 xv = *(const f32x4*)(a.x + (size_t)row * DM + c); const f32x4 gv = *(const f32x4*)(a.g_post + c);
                f32x4 r; r[0] = xv[0] + bf_lo(ov.x) * rs * gv[0]; r[1] = xv[1] + bf_hi(ov.x) * rs * gv[1]; r[2] = xv[2] + bf_lo(ov.y) * rs * gv[2]; r[3] = xv[3] + bf_hi(ov.y) * rs * gv[3];
                *(f32x4*)(a.out + (size_t)row * DM + c) = r; }
        }
    }
#undef IN
#undef SEAM
}

extern "C" void kernel_launch(void* const* d_in, const int* in_sizes, int n_in, void* d_out, int out_size, void* d_ws, size_t ws_size, hipStream_t stream) {
    static int grid = 0;
    if (grid == 0) {
        if (n_in != 19 || ws_size < WS_END) { fprintf(stderr, "kernel_launch: unexpected inputs (n_in %d, ws %zu < %zu)\n", n_in, ws_size, (size_t)WS_END); grid = -1; return; }
        int dev = 0, cus = 0, per_cu = 0;
        hipGetDevice(&dev); hipDeviceGetAttribute(&cus, hipDeviceAttributeMultiprocessorCount, dev);
        if (hipFuncSetAttribute((const void*)mega, hipFuncAttributeMaxDynamicSharedMemorySize, LDS_BYTES) != hipSuccess) { fprintf(stderr, "kernel_launch: hipFuncSetAttribute failed\n"); grid = -1; return; }
        if (hipOccupancyMaxActiveBlocksPerMultiprocessor(&per_cu, (const void*)mega, 512, LDS_BYTES) != hipSuccess || per_cu < 1) { fprintf(stderr, "kernel_launch: occupancy query says %d\n", per_cu); per_cu = 1; }
        (void)hipGetLastError();
        grid = cus;
    }
    if (grid < 0) return;
    Args a{};
    a.x = (const float*)d_in[0]; a.mem = (const float*)d_in[1]; a.g_pre = (const float*)d_in[2]; a.w_in = (const float*)d_in[3]; a.w_pool = (const float*)d_in[4];
    a.pool_scale = (const float*)d_in[5]; a.a_re = (const float*)d_in[6]; a.a_im = (const float*)d_in[7]; a.log_dt = (const float*)d_in[8]; a.b_re = (const float*)d_in[9];
    a.b_im = (const float*)d_in[10]; a.c_re = (const float*)d_in[11]; a.c_im = (const float*)d_in[12]; a.d_skip = (const float*)d_in[13]; a.w_glu = (const float*)d_in[14];
    a.g_mem = (const float*)d_in[15]; a.w_kv = (const float*)d_in[16]; a.w_out = (const float*)d_in[17]; a.g_post = (const float*)d_in[18];
    a.out = (float*)d_out; a.ws = (unsigned char*)d_ws;
    (void)hipMemsetAsync((char*)d_ws + WS_CTL, 0, CTL_BYTES, stream);
#if ONE_LAUNCH
    a.ph_lo = 0; a.ph_hi = 8;
    void* args[] = {&a};
    hipError_t e = hipLaunchCooperativeKernel((const void*)mega, dim3(grid), dim3(512), args, LDS_BYTES, stream);
    if (e != hipSuccess) fprintf(stderr, "kernel_launch: cooperative launch failed: %s (grid %d)\n", hipGetErrorString(e), grid);
#else
    for (int p = 0; p < 8; ++p) { a.ph_lo = p; a.ph_hi = p + 1; hipLaunchKernelGGL(mega, dim3(grid), dim3(512), LDS_BYTES, stream, a); }
#endif
}
```

```cpp
#include <hip/hip_runtime.h>
#include <hip/hip_cooperative_groups.h>
#include <cstdio>
#include <cstdint>
namespace cg = cooperative_groups;

#ifndef ONE_LAUNCH
#define ONE_LAUNCH 1
#endif

#define LAS __attribute__((address_space(3)))
typedef unsigned short bf16_t;
typedef short bf16x8 __attribute__((ext_vector_type(8)));
typedef float f32x4 __attribute__((ext_vector_type(4)));
typedef unsigned u32x4 __attribute__((ext_vector_type(4)));
typedef unsigned u32x2 __attribute__((ext_vector_type(2)));

constexpr int NB = 32, SEQ = 2048, DM = 1024, NTOK = NB * SEQ;
constexpr int POOLW = 384, SSMW = 384, ATTW = 256, INW = 2048;
constexpr int NG = 24, SN = 64, SG = 16;
constexpr int CT = 32, NCH = SEQ / CT, NRC = NB * NCH;
constexpr int UK = CT * SG;
constexpr int UROW = NG * 640 + 64;
constexpr int NMEM = 256, NH = 4, HD = 64;
constexpr float EPS = 1e-6f;

constexpr size_t MB_ = 1024 * 1024;
constexpr size_t WS_HB = 0;
constexpr size_t WS_PROJ = WS_HB + 128 * MB_;
constexpr size_t WS_UBUF = WS_PROJ + 256 * MB_;
constexpr size_t WS_SEND = WS_UBUF + (size_t)NRC * UROW * 2;
constexpr size_t WS_YBUF = WS_SEND + (size_t)NRC * 3072 * 4;
constexpr size_t WS_SSQ = WS_YBUF + (size_t)NTOK * 384 * 2;
constexpr size_t WS_MB = WS_SSQ + (size_t)NTOK * 16 * 4;
constexpr size_t WS_KB = WS_MB + (size_t)8192 * 1024 * 2;
constexpr size_t WS_VT = WS_KB + (size_t)NB * NH * NMEM * HD * 2;
constexpr size_t WS_WIN = WS_VT + (size_t)NB * NH * NMEM * HD * 2;
constexpr size_t WS_WKV = WS_WIN + (size_t)2048 * 1024 * 2;
constexpr size_t WS_WGLU = WS_WKV + (size_t)512 * 1024 * 2;
constexpr size_t WS_WOUT = WS_WGLU + (size_t)768 * 384 * 2;
constexpr size_t WS_BS1 = WS_WOUT + (size_t)1024 * 1024 * 2;
constexpr size_t WS_BS2 = WS_BS1 + (size_t)12 * 256 * 1280 * 2;
constexpr size_t WS_LAMT = WS_BS2 + (size_t)24 * 512 * 640 * 2;
constexpr size_t WS_CTL = WS_LAMT + (size_t)24 * 64 * 2 * 4;
constexpr size_t CTL_BYTES = 16384;
constexpr size_t WS_END = WS_CTL + CTL_BYTES;

constexpr int LDS_BYTES = 147456;

__device__ __forceinline__ unsigned cvt_pk_bf16(float lo, float hi) { unsigned r; asm volatile("v_cvt_pk_bf16_f32 %0, %1, %2" : "=v"(r) : "v"(lo), "v"(hi)); return r; }
__device__ __forceinline__ bf16_t f2bf(float f) { return (bf16_t)(cvt_pk_bf16(f, 0.f) & 0xffffu); }
__device__ __forceinline__ float bf_lo(unsigned w) { return __uint_as_float(w << 16); }
__device__ __forceinline__ float bf_hi(unsigned w) { return __uint_as_float(w & 0xffff0000u); }
__device__ __forceinline__ float sigmoid_f(float v) { return __builtin_amdgcn_rcpf(1.0f + __builtin_amdgcn_exp2f(-1.44269504f * v)); }
__device__ __forceinline__ float silu_f(float v) { return v * sigmoid_f(v); }
__device__ __forceinline__ float gelu_tanh_f(float v) { const float z = 0.7978845608f * (v + 0.044715f * v * v * v); return v * sigmoid_f(2.0f * z); }

namespace pg8 {
constexpr int BM = 256, BK = 64, HALF = 128, HTB = HALF * BK * 2, STAGE_BYTES = 8 * HTB, NXCD = 8, WGM = 8;
__host__ __device__ __forceinline__ int lds_byte(int r, int c) { const int st = (r >> 4) * 2 + (c >> 5), rr = r & 15, cc = c & 31, ob = rr * 64 + cc * 2; return st * 1024 + (ob ^ (((ob >> 9) & 1) << 5)); }
__host__ __device__ __forceinline__ void stage_rc(int b, int& R, int& C) { const int st = b / 1024, sb = b % 1024, swz = sb ^ (((sb >> 9) & 1) << 5); R = (st >> 1) * 16 + swz / 64; C = (st & 1) * 32 + (swz % 64) / 2; }
__host__ __device__ __forceinline__ int perm32(int rho) { const int n = rho >> 4, i = rho & 15; return 8 * (i >> 2) + 4 * n + (i & 3); }

struct Unit { int pm, pn, aux, pad; size_t aoff, boff; };
struct Gemm { const bf16_t* A; const bf16_t* Bt; int lda, ldb, K; };

struct OrderStd {
    int nM, nN, nwg, G, c; size_t astep, bstep;
    __device__ void init(int M, int N, int lda, int ldb, int G_, int c_) { nM = M / BM; nN = N / BM; nwg = nM * nN; G = G_; c = c_; astep = (size_t)BM * lda * 2; bstep = (size_t)BM * ldb * 2; }
    __device__ bool next(int i, Unit& u) const {
        const long L = (long)i * G + c; if (L >= nwg) return false;
        int wgid = (int)L; { const int q = nwg / NXCD, r = nwg % NXCD, xcd = wgid % NXCD, off = wgid / NXCD; wgid = (xcd < r ? xcd * (q + 1) : r * (q + 1) + (xcd - r) * q) + off; }
        const int nig = WGM * nN, gid = wgid / nig, fm = gid * WGM, gsz = (nM - fm) < WGM ? (nM - fm) : WGM;
        u.pm = fm + ((wgid % nig) % gsz); u.pn = (wgid % nig) / gsz; u.aux = 0; u.pad = 0; u.aoff = (size_t)u.pm * astep; u.boff = (size_t)u.pn * bstep; return true;
    }
};
struct OrderS1 {
    int G, c;
    __device__ bool next(int i, Unit& u) const {
        const long L = (long)i * G + c; if (L >= 96) return false;
        u.pm = (int)L / 12; u.pn = (int)L % 12; u.aux = 0; u.pad = 0;
        u.aoff = ((size_t)u.pm * 256 * UROW + (size_t)u.pn * 1280) * 2; u.boff = (size_t)u.pn * 256 * 1280 * 2; return true;
    }
};
struct OrderS2 {
    int G, c;
    __device__ bool next(int i, Unit& u) const {
        const long L = (long)i * G + c; if (L >= 384) return false;
        const int g = (int)L / 16, rem = (int)L % 16; u.pm = rem >> 1; u.pn = rem & 1; u.aux = g; u.pad = 0;
        u.aoff = ((size_t)u.pm * 256 * UROW + (size_t)g * 640) * 2; u.boff = ((size_t)g * 512 + (size_t)u.pn * 256) * 640 * 2; return true;
    }
};

template <class Epi, class Sched>
__device__ __forceinline__ void gemm_phase(LAS unsigned char* lds, const Gemm g, const Sched& S, const Epi& E) {
    const int tid = threadIdx.x, wid = __builtin_amdgcn_readfirstlane(tid >> 6), lane = tid & 63, wr = wid >> 2, wc = wid & 3, fr = lane & 15, fq = lane >> 4;
    const int K = g.K, nt = K / BK;
    unsigned voffA[2], voffB[2];
#pragma unroll
    for (int i = 0; i < 2; ++i) { int R, C; stage_rc(tid * 16 + i * 8192, R, C); const int Rb = Epi::PERM ? ((R & ~31) + perm32(R & 31)) : R;
        voffA[i] = (unsigned)(R * g.lda + C) * 2u; voffB[i] = (unsigned)(Rb * g.ldb + C) * 2u; }
    const size_t kstep = (size_t)(BK * 2);
    const size_t hstepA = (size_t)HALF * g.lda * 2, hstepB = (size_t)HALF * g.ldb * 2;
    const unsigned ldsw = (unsigned)wid * 1024u;
    const int aoff = lds_byte(wr * 64 + fr, fq * 8), boff = lds_byte(wc * 32 + fr, fq * 8);
#define PG8_SA(b, h) (((b) * 2 + (h)) * HTB)
#define PG8_SB(b, h) ((4 + (b) * 2 + (h)) * HTB)
#define PG8_STAGE(bufoff, gbase, voff) do { _Pragma("unroll") for (int _i = 0; _i < 2; ++_i) \
        __builtin_amdgcn_global_load_lds((const unsigned*)((const char*)(gbase) + (voff)[_i]), (LAS unsigned*)(lds + (bufoff) + ldsw + _i * 8192), 16, 0, 0); } while (0)
#define PG8_LDA(dst, b, h) do { _Pragma("unroll") for (int m = 0; m < 4; ++m) _Pragma("unroll") for (int k = 0; k < 2; ++k) dst[m][k] = *(const LAS bf16x8*)(lds + PG8_SA(b, h) + aoff + m * 2048 + k * 1024); } while (0)
#define PG8_LDB(dst, b, h) do { _Pragma("unroll") for (int n = 0; n < 2; ++n) _Pragma("unroll") for (int k = 0; k < 2; ++k) dst[n][k] = *(const LAS bf16x8*)(lds + PG8_SB(b, h) + boff + n * 2048 + k * 1024); } while (0)
#define PG8_MMA(ai, bj, At, Bt) do { __builtin_amdgcn_s_setprio(1); _Pragma("unroll") for (int m = 0; m < 4; ++m) _Pragma("unroll") for (int n = 0; n < 2; ++n) _Pragma("unroll") for (int k = 0; k < 2; ++k) \
        acc[ai][bj][m][n] = __builtin_amdgcn_mfma_f32_16x16x32_bf16(Bt[n][k], At[m][k], acc[ai][bj][m][n], 0, 0, 0); __builtin_amdgcn_s_setprio(0); } while (0)
#define PG8_WAIT_V(n) asm volatile("s_waitcnt vmcnt(" #n ")" ::: "memory")
#define PG8_WAIT_L(n) asm volatile("s_waitcnt lgkmcnt(" #n ")" ::: "memory")
#define PG8_BAR __builtin_amdgcn_s_barrier()
#define PG8_SCHED __builtin_amdgcn_sched_barrier(0)
    Unit cur, nxt; int ui = 0;
    if (!S.next(0, cur)) return;
    f32x4 acc[2][2][4][2];
#pragma unroll
    for (int a = 0; a < 2; ++a)
#pragma unroll
        for (int b = 0; b < 2; ++b)
#pragma unroll
            for (int m = 0; m < 4; ++m)
#pragma unroll
                for (int n = 0; n < 2; ++n) acc[a][b][m][n] = (f32x4){0.f, 0.f, 0.f, 0.f};
    bf16x8 At[4][2], B0[2][2], B1[2][2];
    const char* cA = (const char*)g.A + cur.aoff; const char* cB = (const char*)g.Bt + cur.boff;
    PG8_STAGE(PG8_SB(0, 0), cB, voffB); PG8_STAGE(PG8_SB(0, 1), cB + hstepB, voffB); PG8_STAGE(PG8_SA(0, 0), cA, voffA); PG8_STAGE(PG8_SA(0, 1), cA + hstepA, voffA);
    if (wr == 1) PG8_BAR;
    PG8_WAIT_V(2); PG8_BAR;
    PG8_STAGE(PG8_SB(1, 0), cB + kstep, voffB); PG8_STAGE(PG8_SA(1, 0), cA + kstep, voffA); PG8_STAGE(PG8_SB(1, 1), cB + hstepB + kstep, voffB);
    PG8_WAIT_V(6); PG8_BAR;
    for (;;) {
        const bool has_next = S.next(ui + 1, nxt);
        const char* nA = has_next ? (const char*)g.A + nxt.aoff : cA; const char* nB = has_next ? (const char*)g.Bt + nxt.boff : cB;
#pragma unroll 1
        for (int t = 0; t < nt; t += 2) {
            const bool last = (t == nt - 2);
            const char* a1 = cA + (size_t)(t + 1) * kstep;
            const char* a2 = last ? nA : cA + (size_t)(t + 2) * kstep; const char* b2 = last ? nB : cB + (size_t)(t + 2) * kstep;
            const char* a3 = a2 + kstep; const char* b3 = b2 + kstep;
            PG8_LDB(B0, 0, 0); PG8_LDB(B1, 0, 1); PG8_SCHED; PG8_LDA(At, 0, 0); PG8_STAGE(PG8_SA(1, 1), a1 + hstepA, voffA);
            PG8_WAIT_V(8); PG8_WAIT_L(0); PG8_BAR; PG8_MMA(0, 0, At, B0); PG8_MMA(0, 1, At, B1); PG8_BAR; PG8_SCHED;
            PG8_LDA(At, 0, 1); PG8_STAGE(PG8_SB(0, 0), b2, voffB); PG8_STAGE(PG8_SB(0, 1), b2 + hstepB, voffB); PG8_STAGE(PG8_SA(0, 0), a2, voffA);
            PG8_WAIT_V(8); PG8_WAIT_L(0); PG8_BAR; PG8_MMA(1, 0, At, B0); PG8_MMA(1, 1, At, B1); PG8_BAR; PG8_SCHED;
            PG8_LDB(B0, 1, 0); PG8_LDB(B1, 1, 1); PG8_SCHED; PG8_LDA(At, 1, 0); PG8_STAGE(PG8_SA(0, 1), a2 + hstepA, voffA);
            PG8_WAIT_V(8); PG8_WAIT_L(0); PG8_BAR; PG8_MMA(0, 0, At, B0); PG8_MMA(0, 1, At, B1); PG8_BAR; PG8_SCHED;
            PG8_LDA(At, 1, 1); PG8_STAGE(PG8_SB(1, 0), b3, voffB); PG8_STAGE(PG8_SB(1, 1), b3 + hstepB, voffB); PG8_STAGE(PG8_SA(1, 0), a3, voffA);
            PG8_WAIT_V(8); PG8_WAIT_L(0); PG8_BAR; PG8_MMA(1, 0, At, B0); PG8_MMA(1, 1, At, B1); PG8_BAR; PG8_SCHED;
        }
        if (wr == 0) PG8_BAR;
        E(acc, cur, wr, wc, fr, fq);
        if (!has_next) break;
#pragma unroll
        for (int a = 0; a < 2; ++a)
#pragma unroll
            for (int b = 0; b < 2; ++b)
#pragma unroll
                for (int m = 0; m < 4; ++m)
#pragma unroll
                    for (int n = 0; n < 2; ++n) acc[a][b][m][n] = (f32x4){0.f, 0.f, 0.f, 0.f};
        cur = nxt; cA = nA; cB = nB; ++ui;
        if (wr == 1) PG8_BAR;
    }
    PG8_WAIT_V(0);
    PG8_BAR;
#undef PG8_SA
#undef PG8_SB
#undef PG8_STAGE
#undef PG8_LDA
#undef PG8_LDB
#undef PG8_MMA
#undef PG8_WAIT_V
#undef PG8_WAIT_L
#undef PG8_BAR
#undef PG8_SCHED
}

typedef f32x4 Acc[2][2][4][2];
__device__ __forceinline__ u32x4 pack8(f32x4 v0, f32x4 v1) { u32x4 w; w.x = cvt_pk_bf16(v0[0], v0[1]); w.y = cvt_pk_bf16(v0[2], v0[3]); w.z = cvt_pk_bf16(v1[0], v1[1]); w.w = cvt_pk_bf16(v1[2], v1[3]); return w; }

struct EpiIn {
    static constexpr bool PERM = true;
    bf16_t* PROJ; bf16_t* UBUF;
    __device__ __forceinline__ void operator()(const Acc& acc, const Unit& u, int wr, int wc, int fr, int fq) const {
#pragma unroll
        for (int bj = 0; bj < 2; ++bj) {
            const int blk = 2 * u.pn + bj, col0 = 128 * blk + 32 * wc + 8 * fq;
#pragma unroll
            for (int ai = 0; ai < 2; ++ai)
#pragma unroll
                for (int m = 0; m < 4; ++m) {
                    const int row = u.pm * BM + ai * HALF + wr * 64 + m * 16 + fr;
                    f32x4 v0 = acc[ai][bj][m][0], v1 = acc[ai][bj][m][1];
                    if (blk >= 8) {
#pragma unroll
                        for (int j = 0; j < 4; ++j) { v0[j] = silu_f(v0[j]); v1[j] = silu_f(v1[j]); }
                    } else if (blk >= 6) { v0 = v0 * 0.18033688f; v1 = v1 * 0.18033688f; }
                    const u32x4 w = pack8(v0, v1);
                    if (blk >= 3 && blk < 6) { const int cc = col0 - 384, gg = cc >> 4, cin = cc & 15;
                        *(u32x4*)(UBUF + (size_t)(row >> 5) * UROW + gg * 640 + (row & 31) * 16 + cin) = w; }
                    else *(u32x4*)(PROJ + (size_t)row * INW + col0) = w;
                }
        }
    }
};
struct EpiS1 {
    static constexpr bool PERM = false;
    float* SEND;
    __device__ __forceinline__ void operator()(const Acc& acc, const Unit& u, int wr, int wc, int fr, int fq) const {
        const int row0 = u.pm * BM + wr * 64 + fr, col0 = u.pn * BM + wc * 32 + 4 * fq;
#pragma unroll
        for (int ai = 0; ai < 2; ++ai)
#pragma unroll
            for (int m = 0; m < 4; ++m) { float* rowp = SEND + (size_t)(row0 + ai * HALF + m * 16) * 3072 + col0;
#pragma unroll
                for (int bj = 0; bj < 2; ++bj)
#pragma unroll
                    for (int n = 0; n < 2; ++n) *(f32x4*)(rowp + bj * HALF + n * 16) = acc[ai][bj][m][n]; }
    }
};
struct EpiKV {
    static constexpr bool PERM = true;
    bf16_t* KB; bf16_t* VT;
    __device__ __forceinline__ void operator()(const Acc& acc, const Unit& u, int wr, int wc, int fr, int fq) const {
#pragma unroll
        for (int bj = 0; bj < 2; ++bj) {
            const int c0 = 128 * bj + 32 * wc + 8 * fq, hh = c0 >> 6, d0 = c0 & 63;
#pragma unroll
            for (int ai = 0; ai < 2; ++ai)
#pragma unroll
                for (int m = 0; m < 4; ++m) {
                    const int row = u.pm * BM + ai * HALF + wr * 64 + m * 16 + fr, b = row >> 8, mm = row & 255;
                    const f32x4 v0 = acc[ai][bj][m][0], v1 = acc[ai][bj][m][1];
                    if (u.pn == 0) *(u32x4*)(KB + ((size_t)(b * NH + hh) * NMEM + mm) * HD + d0) = pack8(v0, v1);
                    else { bf16_t* p = VT + ((size_t)(b * NH + hh) * HD + d0) * NMEM + mm;
#pragma unroll
                        for (int j = 0; j < 4; ++j) { p[j * NMEM] = f2bf(v0[j]); p[(4 + j) * NMEM] = f2bf(v1[j]); } }
                }
        }
    }
};
struct EpiS2 {
    static constexpr bool PERM = true;
    bf16_t* YB;
    __device__ __forceinline__ void operator()(const Acc& acc, const Unit& u, int wr, int wc, int fr, int fq) const {
#pragma unroll
        for (int bj = 0; bj < 2; ++bj) {
            const int j0 = u.pn * BM + 128 * bj + 32 * wc + 8 * fq, t = j0 >> 4, cp = j0 & 15;
#pragma unroll
            for (int ai = 0; ai < 2; ++ai)
#pragma unroll
                for (int m = 0; m < 4; ++m) {
                    const int row = u.pm * BM + ai * HALF + wr * 64 + m * 16 + fr;
                    f32x4 v0 = acc[ai][bj][m][0], v1 = acc[ai][bj][m][1];
#pragma unroll
                    for (int j = 0; j < 4; ++j) { v0[j] = gelu_tanh_f(v0[j]); v1[j] = gelu_tanh_f(v1[j]); }
                    *(u32x4*)(YB + ((size_t)row * CT + t) * SSMW + u.aux * SG + cp) = pack8(v0, v1);
                }
        }
    }
};
struct EpiGlu {
    static constexpr bool PERM = true;
    const bf16_t* PROJ; bf16_t* GB;
    __device__ __forceinline__ void operator()(const Acc& acc, const Unit& u, int wr, int wc, int fr, int fq) const {
        const int jj0 = (u.pn * BM + 32 * wc + 8 * fq) >> 1;
        const unsigned row0 = (unsigned)(u.pm * BM + wr * 64 + fr);
        const unsigned goff0 = (row0 * INW + 1024 + 384 + jj0) * 2u, ooff0 = (row0 * DM + 384 + jj0) * 2u;
#pragma unroll
        for (int ai = 0; ai < 2; ++ai)
#pragma unroll
            for (int m = 0; m < 4; ++m) {
                const unsigned goff = goff0 + (unsigned)(ai * HALF + m * 16) * INW * 2u, ooff = ooff0 + (unsigned)(ai * HALF + m * 16) * DM * 2u;
#pragma unroll
                for (int bj = 0; bj < 2; ++bj) {
                    const f32x4 z1 = acc[ai][bj][m][0], z2 = acc[ai][bj][m][1];
                    const u32x2 sg = *(const u32x2*)((const char*)PROJ + (goff + 128u * bj));
                    const float o0 = z1[0] * sigmoid_f(z2[0]) * bf_lo(sg.x), o1 = z1[1] * sigmoid_f(z2[1]) * bf_hi(sg.x);
                    const float o2 = z1[2] * sigmoid_f(z2[2]) * bf_lo(sg.y), o3 = z1[3] * sigmoid_f(z2[3]) * bf_hi(sg.y);
                    u32x2 w; w.x = cvt_pk_bf16(o0, o1); w.y = cvt_pk_bf16(o2, o3);
                    *(u32x2*)((char*)GB + (ooff + 128u * bj)) = w;
                }
                asm volatile("" ::: "memory");
            }
    }
};
struct EpiOut {
    static constexpr bool PERM = true;
    bf16_t* OB; float* SSQ;
    __device__ __forceinline__ void operator()(const Acc& acc, const Unit& u, int wr, int wc, int fr, int fq) const {
#pragma unroll
        for (int ai = 0; ai < 2; ++ai)
#pragma unroll
            for (int m = 0; m < 4; ++m) {
                const int row = u.pm * BM + ai * HALF + wr * 64 + m * 16 + fr;
                float s = 0.f;
#pragma unroll
                for (int bj = 0; bj < 2; ++bj) {
                    const int col0 = u.pn * BM + 128 * bj + 32 * wc + 8 * fq;
                    const f32x4 v0 = acc[ai][bj][m][0], v1 = acc[ai][bj][m][1];
                    s += (v0[0] * v0[0] + v0[1] * v0[1]) + (v0[2] * v0[2] + v0[3] * v0[3]) + (v1[0] * v1[0] + v1[1] * v1[1]) + (v1[2] * v1[2] + v1[3] * v1[3]);
                    *(u32x4*)(OB + (size_t)row * DM + col0) = pack8(v0, v1);
                }
                s += __shfl_xor(s, 16); s += __shfl_xor(s, 32);
                if (fq == 0) SSQ[(size_t)row * 16 + u.pn * 4 + wc] = s;
            }
    }
};
}


#define XB_TMO      128
#define XB_XCNT(j)  (256  + 64 * (j))
#define XB_XSUB(j)  (1280 + 64 * (j))
#define XB_XGEN(j)  (2304 + 64 * (j))
#define XB_TOP      3328
#define XB_TOPGEN   3392
#define XCD_BAR_WORDS 3456
#define XB_SPIN_CAP (1u << 18)
__device__ __forceinline__ unsigned xb_ld(unsigned* p)              { return __hip_atomic_load(p, __ATOMIC_RELAXED, __HIP_MEMORY_SCOPE_AGENT); }
__device__ __forceinline__ unsigned xb_add(unsigned* p, unsigned v) { return __hip_atomic_fetch_add(p, v, __ATOMIC_RELAXED, __HIP_MEMORY_SCOPE_AGENT); }
__device__ __forceinline__ unsigned xb_xcc_id() { return (unsigned)__builtin_amdgcn_s_getreg((3 << 11) | 20) & 0xFu; }
#define XB_SPIN(cond, bar) do { unsigned _sp = 0; while (cond) { __builtin_amdgcn_s_sleep(1); \
    if ((++_sp & 255u) == 0u) { if (xb_ld(&(bar)[XB_TMO])) break; if (_sp > XB_SPIN_CAP) { atomicAdd(&(bar)[XB_TMO], 1u); break; } } } } while (0)
struct XcdBarrier { unsigned* bar; unsigned x; volatile LAS unsigned* st; };
__device__ __forceinline__ XcdBarrier xcd_barrier_post(unsigned* bar, volatile LAS unsigned* st) {
    XcdBarrier b; b.bar = bar; b.x = xb_xcc_id(); b.st = st;
    if (threadIdx.x == 0) (void)xb_add(&bar[XB_XCNT(b.x)], 1u);
    return b;
}
__device__ __forceinline__ void xcd_barrier_complete(unsigned* bar, unsigned x, unsigned& nloc, unsigned& nx) {
    const unsigned G = gridDim.x * gridDim.y * gridDim.z;
    unsigned sum, cnt, mine, sp = 0u;
    for (;;) {
        sum = 0u; cnt = 0u; mine = 0u;
#pragma unroll
        for (unsigned j = 0; j < 16; ++j) { const unsigned c = xb_ld(&bar[XB_XCNT(j)]); sum += c; cnt += (c > 0u) ? 1u : 0u; mine = (j == x) ? c : mine; }
        if (sum == G) break;
        __builtin_amdgcn_s_sleep(1);
        if ((++sp & 255u) == 0u) { if (xb_ld(&bar[XB_TMO])) break; if (sp > XB_SPIN_CAP) { atomicAdd(&bar[XB_TMO], 1u); break; } }
    }
    nloc = mine > 0u ? mine : 1u; nx = cnt > 0u ? cnt : 1u;
}
__device__ __forceinline__ void xcd_barrier(const XcdBarrier& b) {
    asm volatile("s_waitcnt vmcnt(0)" ::: "memory");
    __syncthreads();
    if (threadIdx.x == 0) {
        unsigned* bar = b.bar;
        __builtin_amdgcn_s_waitcnt(0);
        unsigned nloc = b.st[0], nx = b.st[1];
        if (nloc == 0u) { xcd_barrier_complete(bar, b.x, nloc, nx); b.st[0] = nloc; b.st[1] = nx; }
        const unsigned old = xb_add(&bar[XB_XSUB(b.x)], 1u);
        const unsigned gen = old / nloc;
        if (old + 1u == (gen + 1u) * nloc) {
            __builtin_amdgcn_fence(__ATOMIC_RELEASE, "agent");
            asm volatile("s_waitcnt vmcnt(0)" ::: "memory");
            const unsigned og = xb_add(&bar[XB_TOP], 1u);
            const unsigned tg = og / nx;
            if (og + 1u == (tg + 1u) * nx) xb_add(&bar[XB_TOPGEN], 1u);
            else XB_SPIN(xb_ld(&bar[XB_TOPGEN]) == tg, bar);
            __builtin_amdgcn_fence(__ATOMIC_ACQUIRE, "agent");
            xb_add(&bar[XB_XGEN(b.x)], 1u);
            asm volatile("s_waitcnt vmcnt(0)" ::: "memory");
        } else {
            XB_SPIN(xb_ld(&bar[XB_XGEN(b.x)]) == gen, bar);
            __builtin_amdgcn_fence(__ATOMIC_ACQUIRE, "agent");
            asm volatile("s_waitcnt vmcnt(0)" ::: "memory");
        }
    }
    __syncthreads();
}

struct Args {
    const float* x; const float* mem; const float* g_pre; const float* w_in; const float* w_pool; const float* pool_scale;
    const float* a_re; const float* a_im; const float* log_dt; const float* b_re; const float* b_im; const float* c_re; const float* c_im;
    const float* d_skip; const float* w_glu; const float* g_mem; const float* w_kv; const float* w_out; const float* g_post;
    float* out; unsigned char* ws; int ph_lo, ph_hi;
};

__device__ __forceinline__ float wave_sum(float v) {
    v += __shfl_xor(v, 32); v += __shfl_xor(v, 16); v += __shfl_xor(v, 8); v += __shfl_xor(v, 4); v += __shfl_xor(v, 2); v += __shfl_xor(v, 1); return v;
}

__device__ __forceinline__ void rmsnorm_rows(const float* src, const float* g, bf16_t* dst, int nrows, int gwave, int nwaves, int lane) {
    for (int row = 2 * gwave; row < nrows; row += 2 * nwaves) {
        const f32x4* p0 = (const f32x4*)(src + (size_t)row * DM); const f32x4* p1 = p0 + DM / 4;
        f32x4 v0[4], v1[4]; float ss0 = 0.f, ss1 = 0.f;
#pragma unroll
        for (int i = 0; i < 4; ++i) { v0[i] = p0[lane + 64 * i]; v1[i] = p1[lane + 64 * i]; }
#pragma unroll
        for (int i = 0; i < 4; ++i) { ss0 += (v0[i][0] * v0[i][0] + v0[i][1] * v0[i][1]) + (v0[i][2] * v0[i][2] + v0[i][3] * v0[i][3]);
                                      ss1 += (v1[i][0] * v1[i][0] + v1[i][1] * v1[i][1]) + (v1[i][2] * v1[i][2] + v1[i][3] * v1[i][3]); }
        ss0 = wave_sum(ss0); ss1 = wave_sum(ss1);
        const float rs0 = rsqrtf(ss0 * (1.0f / DM) + EPS), rs1 = rsqrtf(ss1 * (1.0f / DM) + EPS);
#pragma unroll
        for (int i = 0; i < 4; ++i) { const f32x4 gv = ((const f32x4*)g)[lane + 64 * i];
            u32x2 w; w.x = cvt_pk_bf16(v0[i][0] * rs0 * gv[0], v0[i][1] * rs0 * gv[1]); w.y = cvt_pk_bf16(v0[i][2] * rs0 * gv[2], v0[i][3] * rs0 * gv[3]);
            *(u32x2*)(dst + (size_t)row * DM + 4 * (lane + 64 * i)) = w;
            w.x = cvt_pk_bf16(v1[i][0] * rs1 * gv[0], v1[i][1] * rs1 * gv[1]); w.y = cvt_pk_bf16(v1[i][2] * rs1 * gv[2], v1[i][3] * rs1 * gv[3]);
            *(u32x2*)(dst + (size_t)(row + 1) * DM + 4 * (lane + 64 * i)) = w; }
    }
}

template <int MODE>
__device__ __forceinline__ void tr_tile(const float* src, int ld_src, int k0, int n0, bf16_t* dst, int ld_dst, LAS float* tile, int tid) {
    __syncthreads();
    for (int e = tid; e < 4096; e += 512) { const int kk = e >> 6, nn = e & 63; tile[kk * 65 + nn] = src[(size_t)(k0 + kk) * ld_src + n0 + nn]; }
    __syncthreads();
    for (int e = tid; e < 4096; e += 512) { const int nn = e >> 6, kk = e & 63; int n = n0 + nn;
        if (MODE == 1) { n = (n < 384) ? (8 * (n >> 2) + (n & 3)) : (8 * ((n - 384) >> 2) + 4 + ((n - 384) & 3)); }
        dst[(size_t)n * ld_dst + k0 + kk] = f2bf(tile[kk * 65 + nn]); }
}

__device__ __forceinline__ void pool_item(unsigned char* ws, int id, int tid) {
    bf16_t* const PROJ = (bf16_t*)(ws + WS_PROJ); bf16_t* const GBUF = (bf16_t*)(ws + WS_HB);
    { const int it = id * 512 + tid;
            const int run = it / 48, cgp = it % 48, b = run >> 7, t0 = (run & 127) * 16, gi = cgp / 12, w = 2 << gi;
            const bf16_t* zb = PROJ + (size_t)b * SEQ * INW + 8 * cgp;
            float S[8];
#pragma unroll
            for (int k = 0; k < 8; ++k) S[k] = 0.f;
            for (int i = 1; i < w; ++i) { const int tt = t0 - i; if (tt >= 0) { const u32x4 v = *(const u32x4*)(zb + (size_t)tt * INW);
                S[0] += bf_lo(v.x); S[1] += bf_hi(v.x); S[2] += bf_lo(v.y); S[3] += bf_hi(v.y); S[4] += bf_lo(v.z); S[5] += bf_hi(v.z); S[6] += bf_lo(v.w); S[7] += bf_hi(v.w); } }
            for (int dt = 0; dt < 16; ++dt) {
                const int t = t0 + dt; const u32x4 v = *(const u32x4*)(zb + (size_t)t * INW);
                float z[8] = {bf_lo(v.x), bf_hi(v.x), bf_lo(v.y), bf_hi(v.y), bf_lo(v.z), bf_hi(v.z), bf_lo(v.w), bf_hi(v.w)};
                const float inv = 1.0f / (float)((t + 1) < w ? (t + 1) : w);
                const u32x4 gv = *(const u32x4*)(PROJ + ((size_t)b * SEQ + t) * INW + 1024 + 8 * cgp);
                const float sg[8] = {bf_lo(gv.x), bf_hi(gv.x), bf_lo(gv.y), bf_hi(gv.y), bf_lo(gv.z), bf_hi(gv.z), bf_lo(gv.w), bf_hi(gv.w)};
                float o[8];
#pragma unroll
                for (int k = 0; k < 8; ++k) { S[k] += z[k]; o[k] = (S[k] * inv - z[k]) * sg[k]; }
                u32x4 wv; wv.x = cvt_pk_bf16(o[0], o[1]); wv.y = cvt_pk_bf16(o[2], o[3]); wv.z = cvt_pk_bf16(o[4], o[5]); wv.w = cvt_pk_bf16(o[6], o[7]);
                *(u32x4*)(GBUF + ((size_t)b * SEQ + t) * DM + 8 * cgp) = wv;
                const int tr = t - w + 1;
                if (tr >= 0) { const u32x4 r = *(const u32x4*)(zb + (size_t)tr * INW);
                    S[0] -= bf_lo(r.x); S[1] -= bf_hi(r.x); S[2] -= bf_lo(r.y); S[3] -= bf_hi(r.y); S[4] -= bf_lo(r.z); S[5] -= bf_hi(r.z); S[6] -= bf_lo(r.w); S[7] -= bf_hi(r.w); }
            }
        }
}
#define QW(k) ((unsigned*)(a.ws + WS_CTL) + 3520 + 64 * (k))

__global__ void __launch_bounds__(512, 2) mega(Args a) {
    extern __shared__ __attribute__((aligned(16))) unsigned char lds_raw[];
    LAS unsigned char* lds = (LAS unsigned char*)lds_raw;
    const int G = gridDim.x, bid = blockIdx.x;
#define TIDS int tid = threadIdx.x; asm volatile("" : "+v"(tid)); const int lane = tid & 63, wave = tid >> 6; (void)lane; (void)wave
#define WSP unsigned char* ws = a.ws; asm volatile("" : "+s"(ws))
#define HB ((bf16_t*)(ws + WS_HB))
#define GBUF ((bf16_t*)(ws + WS_HB))
#define PROJ ((bf16_t*)(ws + WS_PROJ))
#define OBUF ((bf16_t*)(ws + WS_PROJ))
#define UBUF ((bf16_t*)(ws + WS_UBUF))
#define SEND ((float*)(ws + WS_SEND))
#define YBUF ((bf16_t*)(ws + WS_YBUF))
#define SSQ ((float*)(ws + WS_SSQ))
#define MBF ((bf16_t*)(ws + WS_MB))
#define KB ((bf16_t*)(ws + WS_KB))
#define VT ((bf16_t*)(ws + WS_VT))
#define WIN ((bf16_t*)(ws + WS_WIN))
#define WKV ((bf16_t*)(ws + WS_WKV))
#define WGLU ((bf16_t*)(ws + WS_WGLU))
#define WOUT ((bf16_t*)(ws + WS_WOUT))
#define BS1 ((bf16_t*)(ws + WS_BS1))
#define BS2 ((bf16_t*)(ws + WS_BS2))
#define LAMT ((float*)(ws + WS_LAMT))
    const int lo = a.ph_lo, hi = a.ph_hi;
    if (threadIdx.x < 4) ((LAS unsigned*)(lds + 131072))[threadIdx.x] = 0u;
    __syncthreads();
    XcdBarrier gbar; gbar.bar = (unsigned*)(a.ws + WS_CTL); gbar.x = 0; gbar.st = (volatile LAS unsigned*)(lds + 131072);
    if (hi - lo > 1) gbar = xcd_barrier_post((unsigned*)(a.ws + WS_CTL), (volatile LAS unsigned*)(lds + 131072));
    if (hi > 8) cg::this_grid().sync();
#ifndef PH_MASK
#define PH_MASK 0xff
#endif
#ifndef PROBE_MASK
#define PROBE_MASK 0
#endif
#define IN(k) (((PH_MASK >> (k)) & 1) && lo <= (k) && (k) < hi)
#define REPS(k) for (int rep_ = 0; rep_ < (((PROBE_MASK >> (k)) & 1) ? 2 : 1); ++rep_)
#define SEAM(k) do { if (IN(k) && IN((k) + 1)) { xcd_barrier(gbar); } } while (0)

    if (IN(0)) REPS(0) {
        WSP;
        TIDS;
        LAS float* sm = (LAS float*)lds;
        constexpr int N_SSM = NG * CT, N_TRIN = 26 * 16, N_TROUT = 256, N_TRGLU = 72, N_TRKV = 128, N_FOLD = 64;
        constexpr int I1 = N_SSM, I2 = I1 + N_TRIN, I3 = I2 + N_TROUT, I4 = I3 + N_TRGLU, I5 = I4 + N_TRKV, I6 = I5 + N_FOLD;
        for (int item = bid; item < I6; item += G) {
            if (item < I1) {
                const int g = item / CT, j = item % CT;
                LAS float* sBr = sm + 512; LAS float* sBi = sm + 1536; LAS float* sCr = sm + 2560; LAS float* sCi = sm + 3616;
                __syncthreads();
#pragma unroll
                for (int r = 0; r < 2; ++r) { const int idx = tid + 512 * r;
                    sBr[idx] = a.b_re[(size_t)g * 1024 + idx]; sBi[idx] = a.b_im[(size_t)g * 1024 + idx];
                    sCr[(idx >> 6) * 65 + (idx & 63)] = a.c_re[(size_t)g * 1024 + idx]; sCi[(idx >> 6) * 65 + (idx & 63)] = a.c_im[(size_t)g * 1024 + idx]; }
                if (tid < 64) {
                    const int n = tid; const float ar = a.a_re[g * SN + n], ai = a.a_im[g * SN + n], dt = expf(a.log_dt[g]);
                    const float xr = ar * dt, yi = ai * dt;
                    float s0, c0, s1, c1, sy, cy;
                    const float m0 = expf((float)j * xr); sincosf((float)j * yi, &s0, &c0);
                    const float m1 = expf((float)(j + 1) * xr); sincosf((float)(j + 1) * yi, &s1, &c1);
                    const float e1 = expm1f(xr); sincosf(yi, &sy, &cy); const float sh = sinf(0.5f * yi);
                    const float br = e1 * cy - 2.f * sh * sh, bi = (e1 + 1.f) * sy;
                    const float den = 1.f / (ar * ar + ai * ai);
                    const float cr = (br * ar + bi * ai) * den, ci = (bi * ar - br * ai) * den;
                    const float ljr = m0 * c0, lji = m0 * s0;
                    sm[n] = ljr; sm[64 + n] = lji; sm[128 + n] = m1 * c1; sm[192 + n] = m1 * s1;
                    sm[256 + n] = ljr * cr - lji * ci; sm[320 + n] = ljr * ci + lji * cr;
                    if (j == CT - 1) { LAMT[(g * SN + n) * 2] = m1 * c1; LAMT[(g * SN + n) * 2 + 1] = m1 * s1; }
                }
                __syncthreads();
                bf16_t* bs2 = BS2 + (size_t)g * 512 * 640;
                if (tid < 256) {
                    const int cp = tid >> 4, c = tid & 15; float kv = 0.f;
                    for (int n = 0; n < SN; ++n) {
                        const float Br = sBr[n * SG + c], Bi = sBi[n * SG + c];
                        const float Cr = sCr[cp * 65 + n], Ci = sCi[cp * 65 + n];
                        const float lr = sm[256 + n], li = sm[320 + n];
                        const float pr = lr * Br - li * Bi, pi = lr * Bi + li * Br;
                        kv += Cr * pr - Ci * pi;
                    }
                    if (j == 0 && c == cp) kv += a.d_skip[g * SG + cp];
                    const bf16_t kb = f2bf(kv);
                    for (int t = j; t < CT; ++t) { const int s = t - j;
                        bs2[(size_t)(t * SG + cp) * 640 + s * SG + c] = kb;
                        if (j > 0) bs2[(size_t)(s * SG + cp) * 640 + t * SG + c] = 0; }
                } else {
#pragma unroll
                    for (int r = 0; r < 4; ++r) { const int idx = (tid - 256) + 256 * r, cp = idx >> 6, n = idx & 63;
                        const float Cr = sCr[cp * 65 + n], Ci = sCi[cp * 65 + n];
                        const float lr = sm[128 + n], li = sm[192 + n];
                        bs2[(size_t)(j * SG + cp) * 640 + 512 + n] = f2bf(Cr * lr - Ci * li);
                        bs2[(size_t)(j * SG + cp) * 640 + 576 + n] = f2bf(-(Cr * li + Ci * lr)); }
                }
                {
                    const int s = CT - 1 - j, p = g >> 1, gl = g & 1;
                    bf16_t* bs1 = BS1 + (size_t)p * 256 * 1280;
#pragma unroll
                    for (int r = 0; r < 2; ++r) { const int idx = tid + 512 * r, n = idx >> 4, c = idx & 15;
                        const float Br = sBr[n * SG + c], Bi = sBi[n * SG + c];
                        const float lr = sm[256 + n], li = sm[320 + n];
                        bs1[(size_t)(gl * 128 + n) * 1280 + gl * 640 + s * SG + c] = f2bf(lr * Br - li * Bi);
                        bs1[(size_t)(gl * 128 + 64 + n) * 1280 + gl * 640 + s * SG + c] = f2bf(lr * Bi + li * Br); }
                    for (int idx = tid; idx < 128 * 24; idx += 512) { const int rr = idx / 24, q = idx % 24; int col;
                        if (q < 16) col = (1 - gl) * 640 + s * SG + q; else if (q < 20) col = gl * 640 + 512 + 4 * s + (q - 16); else col = (1 - gl) * 640 + 512 + 4 * s + (q - 20);
                        bs1[(size_t)(gl * 128 + rr) * 1280 + col] = 0; }
                }
            } else if (item < I2) { const int it = item - I1, ntl = it / 16, kt = it % 16; tr_tile<0>(a.w_in, INW, 64 * kt, 384 + 64 * ntl, WIN, DM, sm, tid); }
            else if (item < I3) { const int it = item - I2, ntl = it / 16, kt = it % 16; tr_tile<0>(a.w_out, DM, 64 * kt, 64 * ntl, WOUT, DM, sm, tid); }
            else if (item < I4) { const int it = item - I3, ntl = it / 6, kt = it % 6; tr_tile<1>(a.w_glu, 768, 64 * kt, 64 * ntl, WGLU, 384, sm, tid); }
            else if (item < I5) { const int it = item - I4, ntl = it / 16, kt = it % 16; tr_tile<0>(a.w_kv, 512, 64 * kt, 64 * ntl, WKV, DM, sm, tid); }
            else {
                const int it = item - I5, kt = it >> 2, gi = it & 3, k0 = 64 * kt;
                LAS float* At = sm; LAS float* Wp = sm + 64 * 97;
                __syncthreads();
                for (int e = tid; e < 64 * 96; e += 512) { const int kk = e / 96, c = e % 96; At[kk * 97 + c] = a.w_in[(size_t)(k0 + kk) * INW + gi * 96 + c]; }
                for (int e = tid; e < 96 * 96; e += 512) Wp[e] = a.w_pool[(size_t)gi * 9216 + e];
                __syncthreads();
                const int kk = tid & 63, d0 = (tid >> 6) * 12;
                float ac[12];
#pragma unroll
                for (int i = 0; i < 12; ++i) ac[i] = 0.f;
                for (int c = 0; c < 96; ++c) { const float av = At[kk * 97 + c];
#pragma unroll
                    for (int i = 0; i < 12; ++i) ac[i] += av * Wp[c * 96 + d0 + i]; }
#pragma unroll
                for (int i = 0; i < 12; ++i) { const int d = gi * 96 + d0 + i; WIN[(size_t)d * DM + k0 + kk] = f2bf(ac[i] * a.pool_scale[d]); }
            }
        }
        for (int idx = bid * 512 + tid; idx < NRC * NG * 16; idx += G * 512) { const int row = idx / (NG * 16), rem = idx % (NG * 16), g = rem >> 4, q = rem & 15;
            *(u32x4*)(UBUF + (size_t)row * UROW + g * 640 + 512 + q * 8) = (u32x4){0u, 0u, 0u, 0u}; }
        rmsnorm_rows(a.mem, a.g_mem, MBF, NB * NMEM, bid * 8 + wave, G * 8, lane);
        rmsnorm_rows(a.x, a.g_pre, HB, NTOK, bid * 8 + wave, G * 8, lane);
    }
    SEAM(0);

    if (IN(1)) REPS(1) {
        WSP;
        pg8::Gemm g{HB, WIN, DM, DM, DM}; pg8::OrderStd S; S.init(NTOK, INW, DM, DM, G, bid);
        pg8::EpiIn E{PROJ, UBUF};
        pg8::gemm_phase<pg8::EpiIn, pg8::OrderStd>(lds, g, S, E);
    }
    SEAM(1);

    if (IN(2)) REPS(2) {
        WSP;
        { pg8::Gemm g{UBUF, BS1, UROW, 1280, 1280}; pg8::OrderS1 S{G, bid}; pg8::EpiS1 E{SEND};
          pg8::gemm_phase<pg8::EpiS1, pg8::OrderS1>(lds, g, S, E); }
        { pg8::Gemm g{MBF, WKV, DM, DM, DM}; pg8::OrderStd S; S.init(NB * NMEM, 512, DM, DM, G, (bid + 160) % G); pg8::EpiKV E{KB, VT};
          pg8::gemm_phase<pg8::EpiKV, pg8::OrderStd>(lds, g, S, E); }
    }
    SEAM(2);

    if (IN(3)) REPS(3) {
        WSP;
        TIDS;
        for (int idx = bid * 512 + tid; idx < NB * NG * SN; idx += G * 512) {
            const int b = idx / (NG * SN), rem = idx % (NG * SN), g = rem >> 6, n = rem & 63;
            const float lr = LAMT[(g * SN + n) * 2], li = LAMT[(g * SN + n) * 2 + 1];
            float hr = 0.f, hi2 = 0.f;
            for (int k = 0; k < NCH; ++k) {
                const size_t row = (size_t)b * NCH + k;
                UBUF[row * UROW + g * 640 + 512 + n] = f2bf(hr); UBUF[row * UROW + g * 640 + 576 + n] = f2bf(hi2);
                const float sr = SEND[row * 3072 + g * 128 + n], si = SEND[row * 3072 + g * 128 + 64 + n];
                const float nr = lr * hr - li * hi2 + sr, ni = lr * hi2 + li * hr + si; hr = nr; hi2 = ni;
            }
        }
    }
    SEAM(3);

    if (IN(4)) REPS(4) {
        WSP;
        { pg8::Gemm g{UBUF, BS2, UROW, 640, 640}; pg8::OrderS2 S{G, bid}; pg8::EpiS2 E{YBUF};
          pg8::gemm_phase<pg8::EpiS2, pg8::OrderS2>(lds, g, S, E); }
        TIDS;
        { volatile LAS int* slot = (volatile LAS int*)(lds + 131072 + 16);
          for (;;) {
              __syncthreads();
              if (tid == 0) { const unsigned v = __hip_atomic_fetch_add(QW(0), 1u, __ATOMIC_RELAXED, __HIP_MEMORY_SCOPE_AGENT); *slot = (v < 384u) ? (int)v : -1; }
              __syncthreads();
              const int id = *slot;
              if (id < 0) break;
              pool_item(a.ws, id, tid);
          } }
    }
    SEAM(4);

    if (IN(5)) REPS(5) {
        WSP;
#ifndef NO_GLU
        { pg8::Gemm g{YBUF, WGLU, SSMW, SSMW, SSMW}; pg8::OrderStd S; S.init(NTOK, 768, SSMW, SSMW, G, bid); pg8::EpiGlu E{PROJ, GBUF};
          pg8::gemm_phase<pg8::EpiGlu, pg8::OrderStd>(lds, g, S, E); }
#endif
#ifndef NO_ATT
        TIDS;
        constexpr int VOFF = 256 * 144;
        const int fr = lane & 15, fq = lane >> 4;
        for (int item = bid; item < NB * 4 * NH; item += G) {
            const int b = item >> 4, rem = item & 15, h = rem & 3, qt = rem >> 2;
            const bf16_t* Kg = KB + (size_t)(b * NH + h) * NMEM * HD; const bf16_t* Vg = VT + (size_t)(b * NH + h) * HD * NMEM;
            __syncthreads();
            for (int e = tid; e < 2048; e += 512) { const int m = e >> 3, dc = e & 7; const u32x4 v = *(const u32x4*)(Kg + m * HD + dc * 8);
                const int slot = (m & ~31) + 16 * ((m >> 2) & 1) + 4 * ((m >> 3) & 3) + (m & 3);
                *(LAS u32x4*)(lds + slot * 144 + dc * 16) = v; }
            for (int e = tid; e < 2048; e += 512) { const int d = e >> 5, mc = e & 31; const u32x4 v = *(const u32x4*)(Vg + d * NMEM + mc * 8);
                *(LAS u32x4*)(lds + VOFF + d * 528 + mc * 16) = v; }
            __syncthreads();
            for (int pass = 0; pass < 4; ++pass) {
            const size_t token = (size_t)b * SEQ + qt * 512 + pass * 128 + wave * 16 + fr;
            bf16x8 qf[2];
#pragma unroll
            for (int kk = 0; kk < 2; ++kk) qf[kk] = *(const bf16x8*)(PROJ + token * INW + 768 + h * HD + 32 * kk + 8 * fq);
            f32x4 s[8][2];
            float mx = -3.0e38f;
#pragma unroll
            for (int blk = 0; blk < 8; ++blk)
#pragma unroll
                for (int sub = 0; sub < 2; ++sub) {
                    f32x4 ac = (f32x4){0.f, 0.f, 0.f, 0.f};
#pragma unroll
                    for (int kk = 0; kk < 2; ++kk) { const bf16x8 af = *(const LAS bf16x8*)(lds + (32 * blk + 16 * sub + fr) * 144 + (32 * kk + 8 * fq) * 2);
                        ac = __builtin_amdgcn_mfma_f32_16x16x32_bf16(af, qf[kk], ac, 0, 0, 0); }
                    s[blk][sub] = ac;
                    mx = fmaxf(mx, fmaxf(fmaxf(ac[0], ac[1]), fmaxf(ac[2], ac[3])));
                }
            mx = fmaxf(mx, __shfl_xor(mx, 16)); mx = fmaxf(mx, __shfl_xor(mx, 32));
            float sum = 0.f; bf16x8 pb[8];
#pragma unroll
            for (int blk = 0; blk < 8; ++blk) {
                f32x4 p0, p1;
#pragma unroll
                for (int j = 0; j < 4; ++j) { p0[j] = __builtin_amdgcn_exp2f(s[blk][0][j] - mx); p1[j] = __builtin_amdgcn_exp2f(s[blk][1][j] - mx); }
                sum += (p0[0] + p0[1]) + (p0[2] + p0[3]) + (p1[0] + p1[1]) + (p1[2] + p1[3]);
                const u32x4 pw = pg8::pack8(p0, p1); pb[blk] = __builtin_bit_cast(bf16x8, pw);
            }
            sum += __shfl_xor(sum, 16); sum += __shfl_xor(sum, 32);
            const float inv = 1.0f / sum;
#pragma unroll
            for (int dt = 0; dt < 4; ++dt) {
                f32x4 o = (f32x4){0.f, 0.f, 0.f, 0.f};
#pragma unroll
                for (int blk = 0; blk < 8; ++blk) { const bf16x8 vf = *(const LAS bf16x8*)(lds + VOFF + (16 * dt + fr) * 528 + (32 * blk + 8 * fq) * 2);
                    o = __builtin_amdgcn_mfma_f32_16x16x32_bf16(vf, pb[blk], o, 0, 0, 0); }
                const int d0 = 16 * dt + 4 * fq;
                const u32x2 sg = *(const u32x2*)(PROJ + token * INW + 1024 + 768 + h * HD + d0);
                u32x2 wv; wv.x = cvt_pk_bf16(o[0] * inv * bf_lo(sg.x), o[1] * inv * bf_hi(sg.x)); wv.y = cvt_pk_bf16(o[2] * inv * bf_lo(sg.y), o[3] * inv * bf_hi(sg.y));
                *(u32x2*)(GBUF + token * DM + 768 + h * HD + d0) = wv;
            }
            }
        }
#endif
    }
    SEAM(5);

    if (IN(6)) REPS(6) {
        WSP;
        pg8::Gemm g{GBUF, WOUT, DM, DM, DM}; pg8::OrderStd S; S.init(NTOK, DM, DM, DM, G, bid); pg8::EpiOut E{OBUF, SSQ};
        pg8::gemm_phase<pg8::EpiOut, pg8::OrderStd>(lds, g, S, E);
    }
    SEAM(6);
#ifdef PROBE_SYNCS
    for (int q_ = 0; q_ < PROBE_SYNCS; ++q_) xcd_barrier(gbar);
#endif

    if (IN(7)) REPS(7) {
        WSP;
        TIDS;
        for (int row = bid * 8 + wave; row < NTOK; row += G * 8) {
            float ss = (lane < 16) ? SSQ[(size_t)row * 16 + lane] : 0.f;
            ss = wave_sum(ss);
            const float rs = rsqrtf(ss * (1.0f / DM) + EPS);
#pragma unroll
            for (int i = 0; i < 4; ++i) { const int c = 4 * (lane + 64 * i);
                const u32x2 ov = *(const u32x2*)(OBUF + (size_t)row * DM + c);
                const f32x4 xv = *(const f32x4*)(a.x + (size_t)row * DM + c); const f32x4 gv = *(const f32x4*)(a.g_post + c);
                f32x4 r; r[0] = xv[0] + bf_lo(ov.x) * rs * gv[0]; r[1] = xv[1] + bf_hi(ov.x) * rs * gv[1]; r[2] = xv[2] + bf_lo(ov.y) * rs * gv[2]; r[3] = xv[3] + bf_hi(ov.y) * rs * gv[3];
                *(f32x4*)(a.out + (size_t)row * DM + c) = r; }
        }
    }
#undef IN
#undef SEAM
}

extern "C" void kernel_launch(void* const* d_in, const int* in_sizes, int n_in, void* d_out, int out_size, void* d_ws, size_t ws_size, hipStream_t stream) {
    static int grid = 0;
    if (grid == 0) {
        if (n_in != 19 || ws_size < WS_END) { fprintf(stderr, "kernel_launch: unexpected inputs (n_in %d, ws %zu < %zu)\n", n_in, ws_size, (size_t)WS_END); grid = -1; return; }
        int dev = 0, cus = 0, per_cu = 0;
        hipGetDevice(&dev); hipDeviceGetAttribute(&cus, hipDeviceAttributeMultiprocessorCount, dev);
        if (hipFuncSetAttribute((const void*)mega, hipFuncAttributeMaxDynamicSharedMemorySize, LDS_BYTES) != hipSuccess) { fprintf(stderr, "kernel_launch: hipFuncSetAttribute failed\n"); grid = -1; return; }
        if (hipOccupancyMaxActiveBlocksPerMultiprocessor(&per_cu, (const void*)mega, 512, LDS_BYTES) != hipSuccess || per_cu < 1) { fprintf(stderr, "kernel_launch: occupancy query says %d\n", per_cu); per_cu = 1; }
        (void)hipGetLastError();
        grid = cus;
    }
    if (grid < 0) return;
    Args a{};
    a.x = (const float*)d_in[0]; a.mem = (const float*)d_in[1]; a.g_pre = (const float*)d_in[2]; a.w_in = (const float*)d_in[3]; a.w_pool = (const float*)d_in[4];
    a.pool_scale = (const float*)d_in[5]; a.a_re = (const float*)d_in[6]; a.a_im = (const float*)d_in[7]; a.log_dt = (const float*)d_in[8]; a.b_re = (const float*)d_in[9];
    a.b_im = (const float*)d_in[10]; a.c_re = (const float*)d_in[11]; a.c_im = (const float*)d_in[12]; a.d_skip = (const float*)d_in[13]; a.w_glu = (const float*)d_in[14];
    a.g_mem = (const float*)d_in[15]; a.w_kv = (const float*)d_in[16]; a.w_out = (const float*)d_in[17]; a.g_post = (const float*)d_in[18];
    a.out = (float*)d_out; a.ws = (unsigned char*)d_ws;
    (void)hipMemsetAsync((char*)d_ws + WS_CTL, 0, CTL_BYTES, stream);
#if ONE_LAUNCH
    a.ph_lo = 0; a.ph_hi = 8;
    void* args[] = {&a};
    hipError_t e = hipLaunchCooperativeKernel((const void*)mega, dim3(grid), dim3(512), args, LDS_BYTES, stream);
    if (e != hipSuccess) fprintf(stderr, "kernel_launch: cooperative launch failed: %s (grid %d)\n", hipGetErrorString(e), grid);
#else
    for (int p = 0; p < 8; ++p) { a.ph_lo = p; a.ph_hi = p + 1; hipLaunchKernelGGL(mega, dim3(grid), dim3(512), LDS_BYTES, stream, a); }
#endif
}
```

```cpp
#include <hip/hip_runtime.h>
#include <hip/hip_cooperative_groups.h>
#include <cstdio>
#include <cstdint>
namespace cg = cooperative_groups;

#ifndef ONE_LAUNCH
#define ONE_LAUNCH 1
#endif

#define LAS __attribute__((address_space(3)))
typedef unsigned short bf16_t;
typedef short bf16x8 __attribute__((ext_vector_type(8)));
typedef float f32x4 __attribute__((ext_vector_type(4)));
typedef unsigned u32x4 __attribute__((ext_vector_type(4)));
typedef unsigned u32x2 __attribute__((ext_vector_type(2)));

constexpr int NB = 32, SEQ = 2048, DM = 1024, NTOK = NB * SEQ;
constexpr int POOLW = 384, SSMW = 384, ATTW = 256, INW = 2048;
constexpr int NG = 24, SN = 64, SG = 16;
constexpr int CT = 32, NCH = SEQ / CT, NRC = NB * NCH;
constexpr int UK = CT * SG;
constexpr int UROW = NG * 640 + 64;
constexpr int NMEM = 256, NH = 4, HD = 64;
constexpr float EPS = 1e-6f;

constexpr size_t MB_ = 1024 * 1024;
constexpr size_t WS_HB = 0;
constexpr size_t WS_PROJ = WS_HB + 128 * MB_;
constexpr size_t WS_UBUF = WS_PROJ + 256 * MB_;
constexpr size_t WS_SEND = WS_UBUF + (size_t)NRC * UROW * 2;
constexpr size_t WS_YBUF = WS_SEND + (size_t)NRC * 3072 * 4;
constexpr size_t WS_SSQ = WS_YBUF + (size_t)NTOK * 384 * 2;
constexpr size_t WS_MB = WS_SSQ + (size_t)NTOK * 16 * 4;
constexpr size_t WS_KB = WS_MB + (size_t)8192 * 1024 * 2;
constexpr size_t WS_VT = WS_KB + (size_t)NB * NH * NMEM * HD * 2;
constexpr size_t WS_WIN = WS_VT + (size_t)NB * NH * NMEM * HD * 2;
constexpr size_t WS_WKV = WS_WIN + (size_t)2048 * 1024 * 2;
constexpr size_t WS_WGLU = WS_WKV + (size_t)512 * 1024 * 2;
constexpr size_t WS_WOUT = WS_WGLU + (size_t)768 * 384 * 2;
constexpr size_t WS_BS1 = WS_WOUT + (size_t)1024 * 1024 * 2;
constexpr size_t WS_BS2 = WS_BS1 + (size_t)12 * 256 * 1280 * 2;
constexpr size_t WS_LAMT = WS_BS2 + (size_t)24 * 512 * 640 * 2;
constexpr size_t WS_CTL = WS_LAMT + (size_t)24 * 64 * 2 * 4;
constexpr size_t CTL_BYTES = 16384;
constexpr size_t WS_END = WS_CTL + CTL_BYTES;

constexpr int LDS_BYTES = 147456;

__device__ __forceinline__ unsigned cvt_pk_bf16(float lo, float hi) { unsigned r; asm volatile("v_cvt_pk_bf16_f32 %0, %1, %2" : "=v"(r) : "v"(lo), "v"(hi)); return r; }
__device__ __forceinline__ bf16_t f2bf(float f) { return (bf16_t)(cvt_pk_bf16(f, 0.f) & 0xffffu); }
__device__ __forceinline__ float bf_lo(unsigned w) { return __uint_as_float(w << 16); }
__device__ __forceinline__ float bf_hi(unsigned w) { return __uint_as_float(w & 0xffff0000u); }
__device__ __forceinline__ float sigmoid_f(float v) { return __builtin_amdgcn_rcpf(1.0f + __builtin_amdgcn_exp2f(-1.44269504f * v)); }
__device__ __forceinline__ float silu_f(float v) { return v * sigmoid_f(v); }
__device__ __forceinline__ float gelu_tanh_f(float v) { const float z = 0.7978845608f * (v + 0.044715f * v * v * v); return v * sigmoid_f(2.0f * z); }

namespace pg8 {
constexpr int BM = 256, BK = 64, HALF = 128, HTB = HALF * BK * 2, STAGE_BYTES = 8 * HTB, NXCD = 8, WGM = 8;
__host__ __device__ __forceinline__ int lds_byte(int r, int c) { const int st = (r >> 4) * 2 + (c >> 5), rr = r & 15, cc = c & 31, ob = rr * 64 + cc * 2; return st * 1024 + (ob ^ (((ob >> 9) & 1) << 5)); }
__host__ __device__ __forceinline__ void stage_rc(int b, int& R, int& C) { const int st = b / 1024, sb = b % 1024, swz = sb ^ (((sb >> 9) & 1) << 5); R = (st >> 1) * 16 + swz / 64; C = (st & 1) * 32 + (swz % 64) / 2; }
__host__ __device__ __forceinline__ int perm32(int rho) { const int n = rho >> 4, i = rho & 15; return 8 * (i >> 2) + 4 * n + (i & 3); }

struct Unit { int pm, pn, aux, pad; size_t aoff, boff; };
struct Gemm { const bf16_t* A; const bf16_t* Bt; int lda, ldb, K; };

struct OrderStd {
    int nM, nN, nwg, G, c; size_t astep, bstep;
    __device__ void init(int M, int N, int lda, int ldb, int G_, int c_) { nM = M / BM; nN = N / BM; nwg = nM * nN; G = G_; c = c_; astep = (size_t)BM * lda * 2; bstep = (size_t)BM * ldb * 2; }
    __device__ bool next(int i, Unit& u) const {
        const long L = (long)i * G + c; if (L >= nwg) return false;
        int wgid = (int)L; { const int q = nwg / NXCD, r = nwg % NXCD, xcd = wgid % NXCD, off = wgid / NXCD; wgid = (xcd < r ? xcd * (q + 1) : r * (q + 1) + (xcd - r) * q) + off; }
        const int nig = WGM * nN, gid = wgid / nig, fm = gid * WGM, gsz = (nM - fm) < WGM ? (nM - fm) : WGM;
        u.pm = fm + ((wgid % nig) % gsz); u.pn = (wgid % nig) / gsz; u.aux = 0; u.pad = 0; u.aoff = (size_t)u.pm * astep; u.boff = (size_t)u.pn * bstep; return true;
    }
};
struct OrderS1 {
    int G, c;
    __device__ bool next(int i, Unit& u) const {
        const long L = (long)i * G + c; if (L >= 96) return false;
        u.pm = (int)L / 12; u.pn = (int)L % 12; u.aux = 0; u.pad = 0;
        u.aoff = ((size_t)u.pm * 256 * UROW + (size_t)u.pn * 1280) * 2; u.boff = (size_t)u.pn * 256 * 1280 * 2; return true;
    }
};
struct OrderS2 {
    int G, c;
    __device__ bool next(int i, Unit& u) const {
        const long L = (long)i * G + c; if (L >= 384) return false;
        const int g = (int)L / 16, rem = (int)L % 16; u.pm = rem >> 1; u.pn = rem & 1; u.aux = g; u.pad = 0;
        u.aoff = ((size_t)u.pm * 256 * UROW + (size_t)g * 640) * 2; u.boff = ((size_t)g * 512 + (size_t)u.pn * 256) * 640 * 2; return true;
    }
};

template <class Epi, class Sched>
__device__ __forceinline__ void gemm_phase(LAS unsigned char* lds, const Gemm g, const Sched& S, const Epi& E) {
    const int tid = threadIdx.x, wid = __builtin_amdgcn_readfirstlane(tid >> 6), lane = tid & 63, wr = wid >> 2, wc = wid & 3, fr = lane & 15, fq = lane >> 4;
    const int K = g.K, nt = K / BK;
    unsigned voffA[2], voffB[2];
#pragma unroll
    for (int i = 0; i < 2; ++i) { int R, C; stage_rc(tid * 16 + i * 8192, R, C); const int Rb = Epi::PERM ? ((R & ~31) + perm32(R & 31)) : R;
        voffA[i] = (unsigned)(R * g.lda + C) * 2u; voffB[i] = (unsigned)(Rb * g.ldb + C) * 2u; }
    const size_t kstep = (size_t)(BK * 2);
    const size_t hstepA = (size_t)HALF * g.lda * 2, hstepB = (size_t)HALF * g.ldb * 2;
    const unsigned ldsw = (unsigned)wid * 1024u;
    const int aoff = lds_byte(wr * 64 + fr, fq * 8), boff = lds_byte(wc * 32 + fr, fq * 8);
#define PG8_SA(b, h) (((b) * 2 + (h)) * HTB)
#define PG8_SB(b, h) ((4 + (b) * 2 + (h)) * HTB)
#define PG8_STAGE(bufoff, gbase, voff) do { _Pragma("unroll") for (int _i = 0; _i < 2; ++_i) \
        __builtin_amdgcn_global_load_lds((const unsigned*)((const char*)(gbase) + (voff)[_i]), (LAS unsigned*)(lds + (bufoff) + ldsw + _i * 8192), 16, 0, 0); } while (0)
#define PG8_LDA(dst, b, h) do { _Pragma("unroll") for (int m = 0; m < 4; ++m) _Pragma("unroll") for (int k = 0; k < 2; ++k) dst[m][k] = *(const LAS bf16x8*)(lds + PG8_SA(b, h) + aoff + m * 2048 + k * 1024); } while (0)
#define PG8_LDB(dst, b, h) do { _Pragma("unroll") for (int n = 0; n < 2; ++n) _Pragma("unroll") for (int k = 0; k < 2; ++k) dst[n][k] = *(const LAS bf16x8*)(lds + PG8_SB(b, h) + boff + n * 2048 + k * 1024); } while (0)
#define PG8_MMA(ai, bj, At, Bt) do { __builtin_amdgcn_s_setprio(1); _Pragma("unroll") for (int m = 0; m < 4; ++m) _Pragma("unroll") for (int n = 0; n < 2; ++n) _Pragma("unroll") for (int k = 0; k < 2; ++k) \
        acc[ai][bj][m][n] = __builtin_amdgcn_mfma_f32_16x16x32_bf16(Bt[n][k], At[m][k], acc[ai][bj][m][n], 0, 0, 0); __builtin_amdgcn_s_setprio(0); } while (0)
#define PG8_WAIT_V(n) asm volatile("s_waitcnt vmcnt(" #n ")" ::: "memory")
#define PG8_WAIT_L(n) asm volatile("s_waitcnt lgkmcnt(" #n ")" ::: "memory")
#define PG8_BAR __builtin_amdgcn_s_barrier()
#define PG8_SCHED __builtin_amdgcn_sched_barrier(0)
    Unit cur, nxt; int ui = 0;
    if (!S.next(0, cur)) return;
    f32x4 acc[2][2][4][2];
#pragma unroll
    for (int a = 0; a < 2; ++a)
#pragma unroll
        for (int b = 0; b < 2; ++b)
#pragma unroll
            for (int m = 0; m < 4; ++m)
#pragma unroll
                for (int n = 0; n < 2; ++n) acc[a][b][m][n] = (f32x4){0.f, 0.f, 0.f, 0.f};
    bf16x8 At[4][2], B0[2][2], B1[2][2];
    const char* cA = (const char*)g.A + cur.aoff; const char* cB = (const char*)g.Bt + cur.boff;
    PG8_STAGE(PG8_SB(0, 0), cB, voffB); PG8_STAGE(PG8_SB(0, 1), cB + hstepB, voffB); PG8_STAGE(PG8_SA(0, 0), cA, voffA); PG8_STAGE(PG8_SA(0, 1), cA + hstepA, voffA);
    if (wr == 1) PG8_BAR;
    PG8_WAIT_V(2); PG8_BAR;
    PG8_STAGE(PG8_SB(1, 0), cB + kstep, voffB); PG8_STAGE(PG8_SA(1, 0), cA + kstep, voffA); PG8_STAGE(PG8_SB(1, 1), cB + hstepB + kstep, voffB);
    PG8_WAIT_V(6); PG8_BAR;
    for (;;) {
        const bool has_next = S.next(ui + 1, nxt);
        const char* nA = has_next ? (const char*)g.A + nxt.aoff : cA; const char* nB = has_next ? (const char*)g.Bt + nxt.boff : cB;
#pragma unroll 1
        for (int t = 0; t < nt; t += 2) {
            const bool last = (t == nt - 2);
            const char* a1 = cA + (size_t)(t + 1) * kstep;
            const char* a2 = last ? nA : cA + (size_t)(t + 2) * kstep; const char* b2 = last ? nB : cB + (size_t)(t + 2) * kstep;
            const char* a3 = a2 + kstep; const char* b3 = b2 + kstep;
            PG8_LDB(B0, 0, 0); PG8_LDB(B1, 0, 1); PG8_SCHED; PG8_LDA(At, 0, 0); PG8_STAGE(PG8_SA(1, 1), a1 + hstepA, voffA);
            PG8_WAIT_V(8); PG8_WAIT_L(0); PG8_BAR; PG8_MMA(0, 0, At, B0); PG8_MMA(0, 1, At, B1); PG8_BAR; PG8_SCHED;
            PG8_LDA(At, 0, 1); PG8_STAGE(PG8_SB(0, 0), b2, voffB); PG8_STAGE(PG8_SB(0, 1), b2 + hstepB, voffB); PG8_STAGE(PG8_SA(0, 0), a2, voffA);
            PG8_WAIT_V(8); PG8_WAIT_L(0); PG8_BAR; PG8_MMA(1, 0, At, B0); PG8_MMA(1, 1, At, B1); PG8_BAR; PG8_SCHED;
            PG8_LDB(B0, 1, 0); PG8_LDB(B1, 1, 1); PG8_SCHED; PG8_LDA(At, 1, 0); PG8_STAGE(PG8_SA(0, 1), a2 + hstepA, voffA);
            PG8_WAIT_V(8); PG8_WAIT_L(0); PG8_BAR; PG8_MMA(0, 0, At, B0); PG8_MMA(0, 1, At, B1); PG8_BAR; PG8_SCHED;
            PG8_LDA(At, 1, 1); PG8_STAGE(PG8_SB(1, 0), b3, voffB); PG8_STAGE(PG8_SB(1, 1), b3 + hstepB, voffB); PG8_STAGE(PG8_SA(1, 0), a3, voffA);
            PG8_WAIT_V(8); PG8_WAIT_L(0); PG8_BAR; PG8_MMA(1, 0, At, B0); PG8_MMA(1, 1, At, B1); PG8_BAR; PG8_SCHED;
        }
        if (wr == 0) PG8_BAR;
        E(acc, cur, wr, wc, fr, fq);
        if (!has_next) break;
#pragma unroll
        for (int a = 0; a < 2; ++a)
#pragma unroll
            for (int b = 0; b < 2; ++b)
#pragma unroll
                for (int m = 0; m < 4; ++m)
#pragma unroll
                    for (int n = 0; n < 2; ++n) acc[a][b][m][n] = (f32x4){0.f, 0.f, 0.f, 0.f};
        cur = nxt; cA = nA; cB = nB; ++ui;
        if (wr == 1) PG8_BAR;
    }
    PG8_WAIT_V(0);
    PG8_BAR;
#undef PG8_SA
#undef PG8_SB
#undef PG8_STAGE
#undef PG8_LDA
#undef PG8_LDB
#undef PG8_MMA
#undef PG8_WAIT_V
#undef PG8_WAIT_L
#undef PG8_BAR
#undef PG8_SCHED
}

typedef f32x4 Acc[2][2][4][2];
__device__ __forceinline__ u32x4 pack8(f32x4 v0, f32x4 v1) { u32x4 w; w.x = cvt_pk_bf16(v0[0], v0[1]); w.y = cvt_pk_bf16(v0[2], v0[3]); w.z = cvt_pk_bf16(v1[0], v1[1]); w.w = cvt_pk_bf16(v1[2], v1[3]); return w; }

struct EpiIn {
    static constexpr bool PERM = true;
    bf16_t* PROJ; bf16_t* UBUF;
    __device__ __forceinline__ void operator()(const Acc& acc, const Unit& u, int wr, int wc, int fr, int fq) const {
#pragma unroll
        for (int bj = 0; bj < 2; ++bj) {
            const int blk = 2 * u.pn + bj, col0 = 128 * blk + 32 * wc + 8 * fq;
#pragma unroll
            for (int ai = 0; ai < 2; ++ai)
#pragma unroll
                for (int m = 0; m < 4; ++m) {
                    const int row = u.pm * BM + ai * HALF + wr * 64 + m * 16 + fr;
                    f32x4 v0 = acc[ai][bj][m][0], v1 = acc[ai][bj][m][1];
                    if (blk >= 8) {
#pragma unroll
                        for (int j = 0; j < 4; ++j) { v0[j] = silu_f(v0[j]); v1[j] = silu_f(v1[j]); }
                    } else if (blk >= 6) { v0 = v0 * 0.18033688f; v1 = v1 * 0.18033688f; }
                    const u32x4 w = pack8(v0, v1);
                    if (blk >= 3 && blk < 6) { const int cc = col0 - 384, gg = cc >> 4, cin = cc & 15;
                        *(u32x4*)(UBUF + (size_t)(row >> 5) * UROW + gg * 640 + (row & 31) * 16 + cin) = w; }
                    else *(u32x4*)(PROJ + (size_t)row * INW + col0) = w;
                }
        }
    }
};
struct EpiS1 {
    static constexpr bool PERM = false;
    float* SEND;
    __device__ __forceinline__ void operator()(const Acc& acc, const Unit& u, int wr, int wc, int fr, int fq) const {
        const int row0 = u.pm * BM + wr * 64 + fr, col0 = u.pn * BM + wc * 32 + 4 * fq;
#pragma unroll
        for (int ai = 0; ai < 2; ++ai)
#pragma unroll
            for (int m = 0; m < 4; ++m) { float* rowp = SEND + (size_t)(row0 + ai * HALF + m * 16) * 3072 + col0;
#pragma unroll
                for (int bj = 0; bj < 2; ++bj)
#pragma unroll
                    for (int n = 0; n < 2; ++n) *(f32x4*)(rowp + bj * HALF + n * 16) = acc[ai][bj][m][n]; }
    }
};
struct EpiKV {
    static constexpr bool PERM = true;
    bf16_t* KB; bf16_t* VT;
    __device__ __forceinline__ void operator()(const Acc& acc, const Unit& u, int wr, int wc, int fr, int fq) const {
#pragma unroll
        for (int bj = 0; bj < 2; ++bj) {
            const int c0 = 128 * bj + 32 * wc + 8 * fq, hh = c0 >> 6, d0 = c0 & 63;
#pragma unroll
            for (int ai = 0; ai < 2; ++ai)
#pragma unroll
                for (int m = 0; m < 4; ++m) {
                    const int row = u.pm * BM + ai * HALF + wr * 64 + m * 16 + fr, b = row >> 8, mm = row & 255;
                    const f32x4 v0 = acc[ai][bj][m][0], v1 = acc[ai][bj][m][1];
                    if (u.pn == 0) *(u32x4*)(KB + ((size_t)(b * NH + hh) * NMEM + mm) * HD + d0) = pack8(v0, v1);
                    else { bf16_t* p = VT + ((size_t)(b * NH + hh) * HD + d0) * NMEM + mm;
#pragma unroll
                        for (int j = 0; j < 4; ++j) { p[j * NMEM] = f2bf(v0[j]); p[(4 + j) * NMEM] = f2bf(v1[j]); } }
                }
        }
    }
};
struct EpiS2 {
    static constexpr bool PERM = true;
    bf16_t* YB;
    __device__ __forceinline__ void operator()(const Acc& acc, const Unit& u, int wr, int wc, int fr, int fq) const {
#pragma unroll
        for (int bj = 0; bj < 2; ++bj) {
            const int j0 = u.pn * BM + 128 * bj + 32 * wc + 8 * fq, t = j0 >> 4, cp = j0 & 15;
#pragma unroll
            for (int ai = 0; ai < 2; ++ai)
#pragma unroll
                for (int m = 0; m < 4; ++m) {
                    const int row = u.pm * BM + ai * HALF + wr * 64 + m * 16 + fr;
                    f32x4 v0 = acc[ai][bj][m][0], v1 = acc[ai][bj][m][1];
#pragma unroll
                    for (int j = 0; j < 4; ++j) { v0[j] = gelu_tanh_f(v0[j]); v1[j] = gelu_tanh_f(v1[j]); }
                    *(u32x4*)(YB + ((size_t)row * CT + t) * SSMW + u.aux * SG + cp) = pack8(v0, v1);
                }
        }
    }
};
struct EpiGlu {
    static constexpr bool PERM = true;
    const bf16_t* PROJ; bf16_t* GB;
    __device__ __forceinline__ void operator()(const Acc& acc, const Unit& u, int wr, int wc, int fr, int fq) const {
        const int jj0 = (u.pn * BM + 32 * wc + 8 * fq) >> 1;
        const unsigned row0 = (unsigned)(u.pm * BM + wr * 64 + fr);
        const unsigned goff0 = (row0 * INW + 1024 + 384 + jj0) * 2u, ooff0 = (row0 * DM + 384 + jj0) * 2u;
        u32x2 sgv[2][4][2];
#pragma unroll
        for (int ai = 0; ai < 2; ++ai)
#pragma unroll
            for (int m = 0; m < 4; ++m)
#pragma unroll
                for (int bj = 0; bj < 2; ++bj) sgv[ai][m][bj] = *(const u32x2*)((const char*)PROJ + (goff0 + (unsigned)(ai * HALF + m * 16) * INW * 2u + 128u * bj));
        asm volatile("" ::: "memory");
#pragma unroll
        for (int ai = 0; ai < 2; ++ai)
#pragma unroll
            for (int m = 0; m < 4; ++m) {
                const unsigned ooff = ooff0 + (unsigned)(ai * HALF + m * 16) * DM * 2u;
#pragma unroll
                for (int bj = 0; bj < 2; ++bj) {
                    const f32x4 z1 = acc[ai][bj][m][0], z2 = acc[ai][bj][m][1];
                    const u32x2 sg = sgv[ai][m][bj];
                    const float o0 = z1[0] * sigmoid_f(z2[0]) * bf_lo(sg.x), o1 = z1[1] * sigmoid_f(z2[1]) * bf_hi(sg.x);
                    const float o2 = z1[2] * sigmoid_f(z2[2]) * bf_lo(sg.y), o3 = z1[3] * sigmoid_f(z2[3]) * bf_hi(sg.y);
                    u32x2 w; w.x = cvt_pk_bf16(o0, o1); w.y = cvt_pk_bf16(o2, o3);
                    *(u32x2*)((char*)GB + (ooff + 128u * bj)) = w;
                }
            }
    }
};
struct EpiOut {
    static constexpr bool PERM = true;
    bf16_t* OB; float* SSQ;
    __device__ __forceinline__ void operator()(const Acc& acc, const Unit& u, int wr, int wc, int fr, int fq) const {
#pragma unroll
        for (int ai = 0; ai < 2; ++ai)
#pragma unroll
            for (int m = 0; m < 4; ++m) {
                const int row = u.pm * BM + ai * HALF + wr * 64 + m * 16 + fr;
                float s = 0.f;
#pragma unroll
                for (int bj = 0; bj < 2; ++bj) {
                    const int col0 = u.pn * BM + 128 * bj + 32 * wc + 8 * fq;
                    const f32x4 v0 = acc[ai][bj][m][0], v1 = acc[ai][bj][m][1];
                    s += (v0[0] * v0[0] + v0[1] * v0[1]) + (v0[2] * v0[2] + v0[3] * v0[3]) + (v1[0] * v1[0] + v1[1] * v1[1]) + (v1[2] * v1[2] + v1[3] * v1[3]);
                    *(u32x4*)(OB + (size_t)row * DM + col0) = pack8(v0, v1);
                }
                s += __shfl_xor(s, 16); s += __shfl_xor(s, 32);
                if (fq == 0) SSQ[(size_t)row * 16 + u.pn * 4 + wc] = s;
            }
    }
};
}


#define XB_TMO      128
#define XB_XCNT(j)  (256  + 64 * (j))
#define XB_XSUB(j)  (1280 + 64 * (j))
#define XB_XGEN(j)  (2304 + 64 * (j))
#define XB_TOP      3328
#define XB_TOPGEN   3392
#define XCD_BAR_WORDS 3456
#define XB_SPIN_CAP (1u << 18)
__device__ __forceinline__ unsigned xb_ld(unsigned* p)              { return __hip_atomic_load(p, __ATOMIC_RELAXED, __HIP_MEMORY_SCOPE_AGENT); }
__device__ __forceinline__ unsigned xb_add(unsigned* p, unsigned v) { return __hip_atomic_fetch_add(p, v, __ATOMIC_RELAXED, __HIP_MEMORY_SCOPE_AGENT); }
__device__ __forceinline__ unsigned xb_xcc_id() { return (unsigned)__builtin_amdgcn_s_getreg((3 << 11) | 20) & 0xFu; }
#define XB_SPIN(cond, bar) do { unsigned _sp = 0; while (cond) { __builtin_amdgcn_s_sleep(1); \
    if ((++_sp & 255u) == 0u) { if (xb_ld(&(bar)[XB_TMO])) break; if (_sp > XB_SPIN_CAP) { atomicAdd(&(bar)[XB_TMO], 1u); break; } } } } while (0)
struct XcdBarrier { unsigned* bar; unsigned x; volatile LAS unsigned* st; };
__device__ __forceinline__ XcdBarrier xcd_barrier_post(unsigned* bar, volatile LAS unsigned* st) {
    XcdBarrier b; b.bar = bar; b.x = xb_xcc_id(); b.st = st;
    if (threadIdx.x == 0) (void)xb_add(&bar[XB_XCNT(b.x)], 1u);
    return b;
}
__device__ __forceinline__ void xcd_barrier_complete(unsigned* bar, unsigned x, unsigned& nloc, unsigned& nx) {
    const unsigned G = gridDim.x * gridDim.y * gridDim.z;
    unsigned sum, cnt, mine, sp = 0u;
    for (;;) {
        sum = 0u; cnt = 0u; mine = 0u;
#pragma unroll
        for (unsigned j = 0; j < 16; ++j) { const unsigned c = xb_ld(&bar[XB_XCNT(j)]); sum += c; cnt += (c > 0u) ? 1u : 0u; mine = (j == x) ? c : mine; }
        if (sum == G) break;
        __builtin_amdgcn_s_sleep(1);
        if ((++sp & 255u) == 0u) { if (xb_ld(&bar[XB_TMO])) break; if (sp > XB_SPIN_CAP) { atomicAdd(&bar[XB_TMO], 1u); break; } }
    }
    nloc = mine > 0u ? mine : 1u; nx = cnt > 0u ? cnt : 1u;
}
__device__ __forceinline__ void xcd_barrier(const XcdBarrier& b) {
    asm volatile("s_waitcnt vmcnt(0)" ::: "memory");
    __syncthreads();
    if (threadIdx.x == 0) {
        unsigned* bar = b.bar;
        __builtin_amdgcn_s_waitcnt(0);
        unsigned nloc = b.st[0], nx = b.st[1];
        if (nloc == 0u) { xcd_barrier_complete(bar, b.x, nloc, nx); b.st[0] = nloc; b.st[1] = nx; }
        const unsigned old = xb_add(&bar[XB_XSUB(b.x)], 1u);
        const unsigned gen = old / nloc;
        if (old + 1u == (gen + 1u) * nloc) {
            __builtin_amdgcn_fence(__ATOMIC_RELEASE, "agent");
            asm volatile("s_waitcnt vmcnt(0)" ::: "memory");
            const unsigned og = xb_add(&bar[XB_TOP], 1u);
            const unsigned tg = og / nx;
            if (og + 1u == (tg + 1u) * nx) xb_add(&bar[XB_TOPGEN], 1u);
            else XB_SPIN(xb_ld(&bar[XB_TOPGEN]) == tg, bar);
            __builtin_amdgcn_fence(__ATOMIC_ACQUIRE, "agent");
            xb_add(&bar[XB_XGEN(b.x)], 1u);
            asm volatile("s_waitcnt vmcnt(0)" ::: "memory");
        } else {
            XB_SPIN(xb_ld(&bar[XB_XGEN(b.x)]) == gen, bar);
            __builtin_amdgcn_fence(__ATOMIC_ACQUIRE, "agent");
            asm volatile("s_waitcnt vmcnt(0)" ::: "memory");
        }
    }
    __syncthreads();
}

struct Args {
    const float* x; const float* mem; const float* g_pre; const float* w_in; const float* w_pool; const float* pool_scale;
    const float* a_re; const float* a_im; const float* log_dt; const float* b_re; const float* b_im; const float* c_re; const float* c_im;
    const float* d_skip; const float* w_glu; const float* g_mem; const float* w_kv; const float* w_out; const float* g_post;
    float* out; unsigned char* ws; int ph_lo, ph_hi;
};

__device__ __forceinline__ float wave_sum(float v) {
    v += __shfl_xor(v, 32); v += __shfl_xor(v, 16); v += __shfl_xor(v, 8); v += __shfl_xor(v, 4); v += __shfl_xor(v, 2); v += __shfl_xor(v, 1); return v;
}

__device__ __forceinline__ void rmsnorm_rows(const float* src, const float* g, bf16_t* dst, int nrows, int gwave, int nwaves, int lane) {
    int row = 2 * gwave;
    if (row >= nrows) return;
    f32x4 v0[4], v1[4];
    { const f32x4* p0 = (const f32x4*)(src + (size_t)row * DM); const f32x4* p1 = p0 + DM / 4;
#pragma unroll
      for (int i = 0; i < 4; ++i) { v0[i] = __builtin_nontemporal_load(p0 + lane + 64 * i); v1[i] = __builtin_nontemporal_load(p1 + lane + 64 * i); } }
    f32x4 gv[4];
#pragma unroll
    for (int i = 0; i < 4; ++i) gv[i] = ((const f32x4*)g)[lane + 64 * i];
    for (;;) {
        const int nrow = row + 2 * nwaves; const bool more = nrow < nrows;
        f32x4 n0[4], n1[4];
        if (more) { const f32x4* p0 = (const f32x4*)(src + (size_t)nrow * DM); const f32x4* p1 = p0 + DM / 4;
#pragma unroll
            for (int i = 0; i < 4; ++i) { n0[i] = __builtin_nontemporal_load(p0 + lane + 64 * i); n1[i] = __builtin_nontemporal_load(p1 + lane + 64 * i); } }
        float ss0 = 0.f, ss1 = 0.f;
#pragma unroll
        for (int i = 0; i < 4; ++i) { ss0 += (v0[i][0] * v0[i][0] + v0[i][1] * v0[i][1]) + (v0[i][2] * v0[i][2] + v0[i][3] * v0[i][3]);
                                      ss1 += (v1[i][0] * v1[i][0] + v1[i][1] * v1[i][1]) + (v1[i][2] * v1[i][2] + v1[i][3] * v1[i][3]); }
        ss0 = wave_sum(ss0); ss1 = wave_sum(ss1);
        const float rs0 = rsqrtf(ss0 * (1.0f / DM) + EPS), rs1 = rsqrtf(ss1 * (1.0f / DM) + EPS);
#pragma unroll
        for (int i = 0; i < 4; ++i) {
            u32x2 w; w.x = cvt_pk_bf16(v0[i][0] * rs0 * gv[i][0], v0[i][1] * rs0 * gv[i][1]); w.y = cvt_pk_bf16(v0[i][2] * rs0 * gv[i][2], v0[i][3] * rs0 * gv[i][3]);
            *(u32x2*)(dst + (size_t)row * DM + 4 * (lane + 64 * i)) = w;
            w.x = cvt_pk_bf16(v1[i][0] * rs1 * gv[i][0], v1[i][1] * rs1 * gv[i][1]); w.y = cvt_pk_bf16(v1[i][2] * rs1 * gv[i][2], v1[i][3] * rs1 * gv[i][3]);
            *(u32x2*)(dst + (size_t)(row + 1) * DM + 4 * (lane + 64 * i)) = w; }
        if (!more) break;
#pragma unroll
        for (int i = 0; i < 4; ++i) { v0[i] = n0[i]; v1[i] = n1[i]; }
        row = nrow;
    }
}

template <int MODE>
__device__ __forceinline__ void tr_tile(const float* src, int ld_src, int k0, int n0, bf16_t* dst, int ld_dst, LAS float* tile, int tid) {
    __syncthreads();
    for (int e = tid; e < 4096; e += 512) { const int kk = e >> 6, nn = e & 63; tile[kk * 65 + nn] = src[(size_t)(k0 + kk) * ld_src + n0 + nn]; }
    __syncthreads();
    for (int e = tid; e < 4096; e += 512) { const int nn = e >> 6, kk = e & 63; int n = n0 + nn;
        if (MODE == 1) { n = (n < 384) ? (8 * (n >> 2) + (n & 3)) : (8 * ((n - 384) >> 2) + 4 + ((n - 384) & 3)); }
        dst[(size_t)n * ld_dst + k0 + kk] = f2bf(tile[kk * 65 + nn]); }
}

template <int W>
__device__ __forceinline__ void pool_run(const bf16_t* PROJ, bf16_t* GBUF, int b, int t0, int cgp) {
    const bf16_t* zb = PROJ + ((size_t)b * SEQ + t0) * INW + 8 * cgp;
    bf16_t* ob = GBUF + ((size_t)b * SEQ + t0) * DM + 8 * cgp;
    u32x4 hist[W - 1], zc[8], gc[8];
#pragma unroll
    for (int i = 0; i < W - 1; ++i) hist[i] = (t0 - 1 - i >= 0) ? *(const u32x4*)(zb - (size_t)(i + 1) * INW) : (u32x4){0u, 0u, 0u, 0u};
#pragma unroll
    for (int d = 0; d < 8; ++d) { zc[d] = *(const u32x4*)(zb + (size_t)d * INW); gc[d] = *(const u32x4*)(zb + (size_t)d * INW + 1024); }
    float S[8];
#pragma unroll
    for (int q = 0; q < 8; ++q) S[q] = 0.f;
#pragma unroll
    for (int i = 0; i < W - 1; ++i) { const u32x4 v = hist[i];
        S[0] += bf_lo(v.x); S[1] += bf_hi(v.x); S[2] += bf_lo(v.y); S[3] += bf_hi(v.y); S[4] += bf_lo(v.z); S[5] += bf_hi(v.z); S[6] += bf_lo(v.w); S[7] += bf_hi(v.w); }
#pragma unroll
    for (int d = 0; d < 8; ++d) {
        const u32x4 v = zc[d], gv = gc[d];
        const float z[8] = {bf_lo(v.x), bf_hi(v.x), bf_lo(v.y), bf_hi(v.y), bf_lo(v.z), bf_hi(v.z), bf_lo(v.w), bf_hi(v.w)};
        const float sg[8] = {bf_lo(gv.x), bf_hi(gv.x), bf_lo(gv.y), bf_hi(gv.y), bf_lo(gv.z), bf_hi(gv.z), bf_lo(gv.w), bf_hi(gv.w)};
        const int cnt = (t0 + d + 1) < W ? (t0 + d + 1) : W;
        const float inv = 1.0f / (float)cnt;
        float o[8];
#pragma unroll
        for (int q = 0; q < 8; ++q) { S[q] += z[q]; o[q] = (S[q] * inv - z[q]) * sg[q]; }
        u32x4 wv; wv.x = cvt_pk_bf16(o[0], o[1]); wv.y = cvt_pk_bf16(o[2], o[3]); wv.z = cvt_pk_bf16(o[4], o[5]); wv.w = cvt_pk_bf16(o[6], o[7]);
        *(u32x4*)(ob + (size_t)d * DM) = wv;
        const u32x4 r = (d - W + 1 >= 0) ? zc[(d - W + 1 >= 0) ? (d - W + 1) : 0] : hist[(W - 2 - d >= 0) ? (W - 2 - d) : 0];
        S[0] -= bf_lo(r.x); S[1] -= bf_hi(r.x); S[2] -= bf_lo(r.y); S[3] -= bf_hi(r.y); S[4] -= bf_lo(r.z); S[5] -= bf_hi(r.z); S[6] -= bf_lo(r.w); S[7] -= bf_hi(r.w);
    }
}
__device__ __forceinline__ void pool_item(unsigned char* ws, int id, int tid) {
    const bf16_t* PROJ = (const bf16_t*)(ws + WS_PROJ); bf16_t* GBUF = (bf16_t*)(ws + WS_HB);
    const int b = id >> 2, tbase = (id & 3) * 512;
    for (int k = 0; k < 6; ++k) {
        const int j = k * 512 + tid, gi = __builtin_amdgcn_readfirstlane(j / 768), r = j - gi * 768, run = r / 12, cgp = gi * 12 + (r - run * 12), t0 = tbase + run * 8;
        if (gi == 0) pool_run<2>(PROJ, GBUF, b, t0, cgp);
        else if (gi == 1) pool_run<4>(PROJ, GBUF, b, t0, cgp);
        else if (gi == 2) pool_run<8>(PROJ, GBUF, b, t0, cgp);
        else pool_run<16>(PROJ, GBUF, b, t0, cgp);
    }
}
#define QW(k) ((unsigned*)(a.ws + WS_CTL) + 3520 + 64 * (k))

__global__ void __launch_bounds__(512, 2) mega(Args a) {
    extern __shared__ __attribute__((aligned(16))) unsigned char lds_raw[];
    LAS unsigned char* lds = (LAS unsigned char*)lds_raw;
    const int G = gridDim.x, bid = blockIdx.x;
#define TIDS int tid = threadIdx.x; asm volatile("" : "+v"(tid)); const int lane = tid & 63, wave = tid >> 6; (void)lane; (void)wave
#define WSP unsigned char* ws = a.ws; asm volatile("" : "+s"(ws))
#define HB ((bf16_t*)(ws + WS_HB))
#define GBUF ((bf16_t*)(ws + WS_HB))
#define PROJ ((bf16_t*)(ws + WS_PROJ))
#define OBUF ((bf16_t*)(ws + WS_PROJ))
#define UBUF ((bf16_t*)(ws + WS_UBUF))
#define SEND ((float*)(ws + WS_SEND))
#define YBUF ((bf16_t*)(ws + WS_YBUF))
#define SSQ ((float*)(ws + WS_SSQ))
#define MBF ((bf16_t*)(ws + WS_MB))
#define KB ((bf16_t*)(ws + WS_KB))
#define VT ((bf16_t*)(ws + WS_VT))
#define WIN ((bf16_t*)(ws + WS_WIN))
#define WKV ((bf16_t*)(ws + WS_WKV))
#define WGLU ((bf16_t*)(ws + WS_WGLU))
#define WOUT ((bf16_t*)(ws + WS_WOUT))
#define BS1 ((bf16_t*)(ws + WS_BS1))
#define BS2 ((bf16_t*)(ws + WS_BS2))
#define LAMT ((float*)(ws + WS_LAMT))
    const int lo = a.ph_lo, hi = a.ph_hi;
    if (threadIdx.x < 4) ((LAS unsigned*)(lds + 131072))[threadIdx.x] = 0u;
    __syncthreads();
    XcdBarrier gbar; gbar.bar = (unsigned*)(a.ws + WS_CTL); gbar.x = 0; gbar.st = (volatile LAS unsigned*)(lds + 131072);
    if (hi - lo > 1) gbar = xcd_barrier_post((unsigned*)(a.ws + WS_CTL), (volatile LAS unsigned*)(lds + 131072));
    if (hi > 8) cg::this_grid().sync();
#ifndef PH_MASK
#define PH_MASK 0xff
#endif
#ifndef PROBE_MASK
#define PROBE_MASK 0
#endif
#define IN(k) (((PH_MASK >> (k)) & 1) && lo <= (k) && (k) < hi)
#define REPS(k) for (int rep_ = 0; rep_ < (((PROBE_MASK >> (k)) & 1) ? 2 : 1); ++rep_)
#define SEAM(k) do { if (IN(k) && IN((k) + 1)) { xcd_barrier(gbar); } } while (0)

    if (IN(0)) REPS(0) {
        WSP;
        TIDS;
        LAS float* sm = (LAS float*)lds;
        constexpr int N_SSM = NG * CT, N_TRIN = 26 * 16, N_TROUT = 256, N_TRGLU = 72, N_TRKV = 128, N_FOLD = 64;
        constexpr int I1 = N_SSM, I2 = I1 + N_TRIN, I3 = I2 + N_TROUT, I4 = I3 + N_TRGLU, I5 = I4 + N_TRKV, I6 = I5 + N_FOLD;
#ifdef PROBE_ITEMS
        for (int rp_ = 0; rp_ < 2; ++rp_)
#endif
        for (int item = bid; item < I6; item += G) {
            if (item < I1) {
                const int g = item / CT, j = item % CT;
                LAS float* sBr = sm + 512; LAS float* sBi = sm + 1536; LAS float* sCr = sm + 2560; LAS float* sCi = sm + 3616;
                __syncthreads();
#pragma unroll
                for (int r = 0; r < 2; ++r) { const int idx = tid + 512 * r;
                    sBr[idx] = a.b_re[(size_t)g * 1024 + idx]; sBi[idx] = a.b_im[(size_t)g * 1024 + idx];
                    sCr[(idx >> 6) * 65 + (idx & 63)] = a.c_re[(size_t)g * 1024 + idx]; sCi[(idx >> 6) * 65 + (idx & 63)] = a.c_im[(size_t)g * 1024 + idx]; }
                if (tid < 64) {
                    const int n = tid; const float ar = a.a_re[g * SN + n], ai = a.a_im[g * SN + n], dt = expf(a.log_dt[g]);
                    const float xr = ar * dt, yi = ai * dt;
                    float s0, c0, s1, c1, sy, cy;
                    const float m0 = expf((float)j * xr); sincosf((float)j * yi, &s0, &c0);
                    const float m1 = expf((float)(j + 1) * xr); sincosf((float)(j + 1) * yi, &s1, &c1);
                    const float e1 = expm1f(xr); sincosf(yi, &sy, &cy); const float sh = sinf(0.5f * yi);
                    const float br = e1 * cy - 2.f * sh * sh, bi = (e1 + 1.f) * sy;
                    const float den = 1.f / (ar * ar + ai * ai);
                    const float cr = (br * ar + bi * ai) * den, ci = (bi * ar - br * ai) * den;
                    const float ljr = m0 * c0, lji = m0 * s0;
                    sm[n] = ljr; sm[64 + n] = lji; sm[128 + n] = m1 * c1; sm[192 + n] = m1 * s1;
                    sm[256 + n] = ljr * cr - lji * ci; sm[320 + n] = ljr * ci + lji * cr;
                    if (j == CT - 1) { LAMT[(g * SN + n) * 2] = m1 * c1; LAMT[(g * SN + n) * 2 + 1] = m1 * s1; }
                }
                __syncthreads();
                bf16_t* bs2 = BS2 + (size_t)g * 512 * 640;
                if (tid < 256) {
                    const int cp = tid >> 4, c = tid & 15; float kv = 0.f;
                    for (int n = 0; n < SN; ++n) {
                        const float Br = sBr[n * SG + c], Bi = sBi[n * SG + c];
                        const float Cr = sCr[cp * 65 + n], Ci = sCi[cp * 65 + n];
                        const float lr = sm[256 + n], li = sm[320 + n];
                        const float pr = lr * Br - li * Bi, pi = lr * Bi + li * Br;
                        kv += Cr * pr - Ci * pi;
                    }
                    if (j == 0 && c == cp) kv += a.d_skip[g * SG + cp];
                    const bf16_t kb = f2bf(kv);
                    for (int t = j; t < CT; ++t) { const int s = t - j;
                        bs2[(size_t)(t * SG + cp) * 640 + s * SG + c] = kb;
                        if (j > 0) bs2[(size_t)(s * SG + cp) * 640 + t * SG + c] = 0; }
                } else {
#pragma unroll
                    for (int r = 0; r < 4; ++r) { const int idx = (tid - 256) + 256 * r, cp = idx >> 6, n = idx & 63;
                        const float Cr = sCr[cp * 65 + n], Ci = sCi[cp * 65 + n];
                        const float lr = sm[128 + n], li = sm[192 + n];
                        bs2[(size_t)(j * SG + cp) * 640 + 512 + n] = f2bf(Cr * lr - Ci * li);
                        bs2[(size_t)(j * SG + cp) * 640 + 576 + n] = f2bf(-(Cr * li + Ci * lr)); }
                }
                {
                    const int s = CT - 1 - j, p = g >> 1, gl = g & 1;
                    bf16_t* bs1 = BS1 + (size_t)p * 256 * 1280;
#pragma unroll
                    for (int r = 0; r < 2; ++r) { const int idx = tid + 512 * r, n = idx >> 4, c = idx & 15;
                        const float Br = sBr[n * SG + c], Bi = sBi[n * SG + c];
                        const float lr = sm[256 + n], li = sm[320 + n];
                        bs1[(size_t)(gl * 128 + n) * 1280 + gl * 640 + s * SG + c] = f2bf(lr * Br - li * Bi);
                        bs1[(size_t)(gl * 128 + 64 + n) * 1280 + gl * 640 + s * SG + c] = f2bf(lr * Bi + li * Br); }
                    for (int idx = tid; idx < 128 * 24; idx += 512) { const int rr = idx / 24, q = idx % 24; int col;
                        if (q < 16) col = (1 - gl) * 640 + s * SG + q; else if (q < 20) col = gl * 640 + 512 + 4 * s + (q - 16); else col = (1 - gl) * 640 + 512 + 4 * s + (q - 20);
                        bs1[(size_t)(gl * 128 + rr) * 1280 + col] = 0; }
                }
            } else if (item < I2) { const int it = item - I1, ntl = it / 16, kt = it % 16; tr_tile<0>(a.w_in, INW, 64 * kt, 384 + 64 * ntl, WIN, DM, sm, tid); }
            else if (item < I3) { const int it = item - I2, ntl = it / 16, kt = it % 16; tr_tile<0>(a.w_out, DM, 64 * kt, 64 * ntl, WOUT, DM, sm, tid); }
            else if (item < I4) { const int it = item - I3, ntl = it / 6, kt = it % 6; tr_tile<1>(a.w_glu, 768, 64 * kt, 64 * ntl, WGLU, 384, sm, tid); }
            else if (item < I5) { const int it = item - I4, ntl = it / 16, kt = it % 16; tr_tile<0>(a.w_kv, 512, 64 * kt, 64 * ntl, WKV, DM, sm, tid); }
            else {
                const int it = item - I5, kt = it >> 2, gi = it & 3, k0 = 64 * kt;
                LAS float* At = sm; LAS float* Wp = sm + 64 * 97;
                __syncthreads();
                for (int e = tid; e < 64 * 96; e += 512) { const int kk = e / 96, c = e % 96; At[kk * 97 + c] = a.w_in[(size_t)(k0 + kk) * INW + gi * 96 + c]; }
                for (int e = tid; e < 96 * 96; e += 512) Wp[e] = a.w_pool[(size_t)gi * 9216 + e];
                __syncthreads();
                const int kk = tid & 63, d0 = (tid >> 6) * 12;
                float ac[12];
#pragma unroll
                for (int i = 0; i < 12; ++i) ac[i] = 0.f;
                for (int c = 0; c < 96; ++c) { const float av = At[kk * 97 + c];
#pragma unroll
                    for (int i = 0; i < 12; ++i) ac[i] += av * Wp[c * 96 + d0 + i]; }
#pragma unroll
                for (int i = 0; i < 12; ++i) { const int d = gi * 96 + d0 + i; WIN[(size_t)d * DM + k0 + kk] = f2bf(ac[i] * a.pool_scale[d]); }
            }
        }
        for (int idx = bid * 512 + tid; idx < NRC * NG * 16; idx += G * 512) { const int row = idx / (NG * 16), rem = idx % (NG * 16), g = rem >> 4, q = rem & 15;
            *(u32x4*)(UBUF + (size_t)row * UROW + g * 640 + 512 + q * 8) = (u32x4){0u, 0u, 0u, 0u}; }
        rmsnorm_rows(a.mem, a.g_mem, MBF, NB * NMEM, bid * 8 + wave, G * 8, lane);
        rmsnorm_rows(a.x, a.g_pre, HB, NTOK, bid * 8 + wave, G * 8, lane);
    }
    SEAM(0);

    if (IN(1)) REPS(1) {
        WSP;
        pg8::Gemm g{HB, WIN, DM, DM, DM}; pg8::OrderStd S; S.init(NTOK, INW, DM, DM, G, bid);
        pg8::EpiIn E{PROJ, UBUF};
        pg8::gemm_phase<pg8::EpiIn, pg8::OrderStd>(lds, g, S, E);
    }
    SEAM(1);

    if (IN(2)) REPS(2) {
        WSP;
        { pg8::Gemm g{UBUF, BS1, UROW, 1280, 1280}; pg8::OrderS1 S{G, bid}; pg8::EpiS1 E{SEND};
          pg8::gemm_phase<pg8::EpiS1, pg8::OrderS1>(lds, g, S, E); }
        {
            TIDS;
            asm volatile("s_waitcnt vmcnt(0)" ::: "memory"); __syncthreads();
            for (int L = bid; L < 96; L += G) {
                const int pm = L / 12, p = L % 12, b = 4 * pm + (tid >> 7), g = 2 * p + ((tid >> 6) & 1), n = tid & 63;
                const float lr = LAMT[(g * SN + n) * 2], li = LAMT[(g * SN + n) * 2 + 1];
                float hr = 0.f, hi2 = 0.f;
                for (int k = 0; k < NCH; ++k) {
                    const size_t row = (size_t)b * NCH + k;
                    UBUF[row * UROW + g * 640 + 512 + n] = f2bf(hr); UBUF[row * UROW + g * 640 + 576 + n] = f2bf(hi2);
                    const float sr = SEND[row * 3072 + g * 128 + n], si = SEND[row * 3072 + g * 128 + 64 + n];
                    const float nr = lr * hr - li * hi2 + sr, ni = lr * hi2 + li * hr + si; hr = nr; hi2 = ni;
                }
            }
        }
        { pg8::Gemm g{MBF, WKV, DM, DM, DM}; pg8::OrderStd S; S.init(NB * NMEM, 512, DM, DM, G, (bid + 160) % G); pg8::EpiKV E{KB, VT};
          pg8::gemm_phase<pg8::EpiKV, pg8::OrderStd>(lds, g, S, E); }
    }
    SEAM(2);

    if (IN(4)) REPS(4) {
        WSP;
        { pg8::Gemm g{UBUF, BS2, UROW, 640, 640}; pg8::OrderS2 S{G, bid}; pg8::EpiS2 E{YBUF};
          pg8::gemm_phase<pg8::EpiS2, pg8::OrderS2>(lds, g, S, E); }
        TIDS;
        { volatile LAS int* slot = (volatile LAS int*)(lds + 131072 + 16);
          for (;;) {
              __syncthreads();
              if (tid == 0) { const unsigned v = __hip_atomic_fetch_add(QW(0), 1u, __ATOMIC_RELAXED, __HIP_MEMORY_SCOPE_AGENT); *slot = (v < 128u) ? (int)v : -1; }
              __syncthreads();
              const int id = *slot;
              if (id < 0) break;
              pool_item(a.ws, id, tid);
          } }
    }
    SEAM(4);

    if (IN(5)) REPS(5) {
        WSP;
#ifndef NO_GLU
        { pg8::Gemm g{YBUF, WGLU, SSMW, SSMW, SSMW}; pg8::OrderStd S; S.init(NTOK, 768, SSMW, SSMW, G, bid); pg8::EpiGlu E{PROJ, GBUF};
          pg8::gemm_phase<pg8::EpiGlu, pg8::OrderStd>(lds, g, S, E); }
#endif
#ifndef NO_ATT
        TIDS;
        constexpr int VOFF = 256 * 144;
        const int fr = lane & 15, fq = lane >> 4;
#ifdef PROBE_ATT
        for (int rp_ = 0; rp_ < 2; ++rp_)
#endif
        for (int item = bid; item < NB * 4 * NH; item += G) {
            const int b = item >> 4, rem = item & 15, h = rem & 3, qt = rem >> 2;
            const bf16_t* Kg = KB + (size_t)(b * NH + h) * NMEM * HD; const bf16_t* Vg = VT + (size_t)(b * NH + h) * HD * NMEM;
            const size_t tok0 = (size_t)b * SEQ + qt * 512 + wave * 16 + fr;
            bf16x8 qall[4][2]; u32x2 gall[4][4];
#pragma unroll
            for (int pass = 0; pass < 4; ++pass) {
#pragma unroll
                for (int kk = 0; kk < 2; ++kk) qall[pass][kk] = *(const bf16x8*)(PROJ + (tok0 + pass * 128) * INW + 768 + h * HD + 32 * kk + 8 * fq);
#pragma unroll
                for (int dt = 0; dt < 4; ++dt) gall[pass][dt] = *(const u32x2*)(PROJ + (tok0 + pass * 128) * INW + 1024 + 768 + h * HD + 16 * dt + 4 * fq);
            }
            __syncthreads();
            for (int e = tid; e < 2048; e += 512) { const int m = e >> 3, dc = e & 7; const u32x4 v = *(const u32x4*)(Kg + m * HD + dc * 8);
                const int slot = (m & ~31) + 16 * ((m >> 2) & 1) + 4 * ((m >> 3) & 3) + (m & 3);
                *(LAS u32x4*)(lds + slot * 144 + dc * 16) = v; }
            for (int e = tid; e < 2048; e += 512) { const int d = e >> 5, mc = e & 31; const u32x4 v = *(const u32x4*)(Vg + d * NMEM + mc * 8);
                *(LAS u32x4*)(lds + VOFF + d * 528 + mc * 16) = v; }
            __syncthreads();
#pragma unroll
            for (int pass = 0; pass < 4; ++pass) {
            const size_t token = tok0 + pass * 128;
            bf16x8 qf[2];
#pragma unroll
            for (int kk = 0; kk < 2; ++kk) qf[kk] = qall[pass][kk];
            f32x4 s[8][2];
            float mx = -3.0e38f;
#pragma unroll
            for (int blk = 0; blk < 8; ++blk)
#pragma unroll
                for (int sub = 0; sub < 2; ++sub) {
                    f32x4 ac = (f32x4){0.f, 0.f, 0.f, 0.f};
#pragma unroll
                    for (int kk = 0; kk < 2; ++kk) { const bf16x8 af = *(const LAS bf16x8*)(lds + (32 * blk + 16 * sub + fr) * 144 + (32 * kk + 8 * fq) * 2);
                        ac = __builtin_amdgcn_mfma_f32_16x16x32_bf16(af, qf[kk], ac, 0, 0, 0); }
                    s[blk][sub] = ac;
                    mx = fmaxf(mx, fmaxf(fmaxf(ac[0], ac[1]), fmaxf(ac[2], ac[3])));
                }
            mx = fmaxf(mx, __shfl_xor(mx, 16)); mx = fmaxf(mx, __shfl_xor(mx, 32));
            float sum = 0.f; bf16x8 pb[8];
#pragma unroll
            for (int blk = 0; blk < 8; ++blk) {
                f32x4 p0, p1;
#pragma unroll
                for (int j = 0; j < 4; ++j) { p0[j] = __builtin_amdgcn_exp2f(s[blk][0][j] - mx); p1[j] = __builtin_amdgcn_exp2f(s[blk][1][j] - mx); }
                sum += (p0[0] + p0[1]) + (p0[2] + p0[3]) + (p1[0] + p1[1]) + (p1[2] + p1[3]);
                const u32x4 pw = pg8::pack8(p0, p1); pb[blk] = __builtin_bit_cast(bf16x8, pw);
            }
            sum += __shfl_xor(sum, 16); sum += __shfl_xor(sum, 32);
            const float inv = 1.0f / sum;
#pragma unroll
            for (int dt = 0; dt < 4; ++dt) {
                f32x4 o = (f32x4){0.f, 0.f, 0.f, 0.f};
#pragma unroll
                for (int blk = 0; blk < 8; ++blk) { const bf16x8 vf = *(const LAS bf16x8*)(lds + VOFF + (16 * dt + fr) * 528 + (32 * blk + 8 * fq) * 2);
                    o = __builtin_amdgcn_mfma_f32_16x16x32_bf16(vf, pb[blk], o, 0, 0, 0); }
                const int d0 = 16 * dt + 4 * fq;
                const u32x2 sg = gall[pass][dt];
                u32x2 wv; wv.x = cvt_pk_bf16(o[0] * inv * bf_lo(sg.x), o[1] * inv * bf_hi(sg.x)); wv.y = cvt_pk_bf16(o[2] * inv * bf_lo(sg.y), o[3] * inv * bf_hi(sg.y));
                *(u32x2*)(GBUF + token * DM + 768 + h * HD + d0) = wv;
            }
            }
        }
#endif
    }
    SEAM(5);

    if (IN(6)) REPS(6) {
        WSP;
        pg8::Gemm g{GBUF, WOUT, DM, DM, DM}; pg8::OrderStd S; S.init(NTOK, DM, DM, DM, G, bid); pg8::EpiOut E{OBUF, SSQ};
        pg8::gemm_phase<pg8::EpiOut, pg8::OrderStd>(lds, g, S, E);
    }
    SEAM(6);
#ifdef PROBE_SYNCS
    for (int q_ = 0; q_ < PROBE_SYNCS; ++q_) xcd_barrier(gbar);
#endif

    if (IN(7)) REPS(7) {
        WSP;
        TIDS;
        {
            const int nw = G * 8; int row = 2 * (bid * 8 + wave);
            f32x4 gv[4];
#pragma unroll
            for (int i = 0; i < 4; ++i) gv[i] = *(const f32x4*)(a.g_post + 4 * (lane + 64 * i));
            if (row < NTOK) {
                float sq0 = (lane < 16) ? SSQ[(size_t)row * 16 + lane] : 0.f, sq1 = (lane < 16) ? SSQ[(size_t)(row + 1) * 16 + lane] : 0.f;
                u32x2 o0[4], o1[4]; f32x4 x0[4], x1[4];
#pragma unroll
                for (int i = 0; i < 4; ++i) { const int c = 4 * (lane + 64 * i);
                    o0[i] = *(const u32x2*)(OBUF + (size_t)row * DM + c); o1[i] = *(const u32x2*)(OBUF + (size_t)(row + 1) * DM + c);
                    x0[i] = __builtin_nontemporal_load((const f32x4*)(a.x + (size_t)row * DM + c)); x1[i] = __builtin_nontemporal_load((const f32x4*)(a.x + (size_t)(row + 1) * DM + c)); }
                for (;;) {
                    const int nrow = row + 2 * nw; const bool more = nrow < NTOK;
                    float nq0 = 0.f, nq1 = 0.f; u32x2 p0[4], p1[4]; f32x4 y0[4], y1[4];
                    if (more) {
                        nq0 = (lane < 16) ? SSQ[(size_t)nrow * 16 + lane] : 0.f; nq1 = (lane < 16) ? SSQ[(size_t)(nrow + 1) * 16 + lane] : 0.f;
#pragma unroll
                        for (int i = 0; i < 4; ++i) { const int c = 4 * (lane + 64 * i);
                            p0[i] = *(const u32x2*)(OBUF + (size_t)nrow * DM + c); p1[i] = *(const u32x2*)(OBUF + (size_t)(nrow + 1) * DM + c);
                            y0[i] = __builtin_nontemporal_load((const f32x4*)(a.x + (size_t)nrow * DM + c)); y1[i] = __builtin_nontemporal_load((const f32x4*)(a.x + (size_t)(nrow + 1) * DM + c)); }
                    }
                    const float rs0 = rsqrtf(wave_sum(sq0) * (1.0f / DM) + EPS), rs1 = rsqrtf(wave_sum(sq1) * (1.0f / DM) + EPS);
#pragma unroll
                    for (int i = 0; i < 4; ++i) { const int c = 4 * (lane + 64 * i);
                        f32x4 r;
                        r[0] = x0[i][0] + bf_lo(o0[i].x) * rs0 * gv[i][0]; r[1] = x0[i][1] + bf_hi(o0[i].x) * rs0 * gv[i][1]; r[2] = x0[i][2] + bf_lo(o0[i].y) * rs0 * gv[i][2]; r[3] = x0[i][3] + bf_hi(o0[i].y) * rs0 * gv[i][3];
                        __builtin_nontemporal_store(r, (f32x4*)(a.out + (size_t)row * DM + c));
                        r[0] = x1[i][0] + bf_lo(o1[i].x) * rs1 * gv[i][0]; r[1] = x1[i][1] + bf_hi(o1[i].x) * rs1 * gv[i][1]; r[2] = x1[i][2] + bf_lo(o1[i].y) * rs1 * gv[i][2]; r[3] = x1[i][3] + bf_hi(o1[i].y) * rs1 * gv[i][3];
                        __builtin_nontemporal_store(r, (f32x4*)(a.out + (size_t)(row + 1) * DM + c)); }
                    if (!more) break;
                    sq0 = nq0; sq1 = nq1;
#pragma unroll
                    for (int i = 0; i < 4; ++i) { o0[i] = p0[i]; o1[i] = p1[i]; x0[i] = y0[i]; x1[i] = y1[i]; }
                    row = nrow;
                }
            }
        }
    }
#undef IN
#undef SEAM
}

extern "C" void kernel_launch(void* const* d_in, const int* in_sizes, int n_in, void* d_out, int out_size, void* d_ws, size_t ws_size, hipStream_t stream) {
    static int grid = 0;
    if (grid == 0) {
        if (n_in != 19 || ws_size < WS_END) { fprintf(stderr, "kernel_launch: unexpected inputs (n_in %d, ws %zu < %zu)\n", n_in, ws_size, (size_t)WS_END); grid = -1; return; }
        int dev = 0, cus = 0, per_cu = 0;
        hipGetDevice(&dev); hipDeviceGetAttribute(&cus, hipDeviceAttributeMultiprocessorCount, dev);
        if (hipFuncSetAttribute((const void*)mega, hipFuncAttributeMaxDynamicSharedMemorySize, LDS_BYTES) != hipSuccess) { fprintf(stderr, "kernel_launch: hipFuncSetAttribute failed\n"); grid = -1; return; }
        if (hipOccupancyMaxActiveBlocksPerMultiprocessor(&per_cu, (const void*)mega, 512, LDS_BYTES) != hipSuccess || per_cu < 1) { fprintf(stderr, "kernel_launch: occupancy query says %d\n", per_cu); per_cu = 1; }
        (void)hipGetLastError();
        grid = cus;
    }
    if (grid < 0) return;
    Args a{};
    a.x = (const float*)d_in[0]; a.mem = (const float*)d_in[1]; a.g_pre = (const float*)d_in[2]; a.w_in = (const float*)d_in[3]; a.w_pool = (const float*)d_in[4];
    a.pool_scale = (const float*)d_in[5]; a.a_re = (const float*)d_in[6]; a.a_im = (const float*)d_in[7]; a.log_dt = (const float*)d_in[8]; a.b_re = (const float*)d_in[9];
    a.b_im = (const float*)d_in[10]; a.c_re = (const float*)d_in[11]; a.c_im = (const float*)d_in[12]; a.d_skip = (const float*)d_in[13]; a.w_glu = (const float*)d_in[14];
    a.g_mem = (const float*)d_in[15]; a.w_kv = (const float*)d_in[16]; a.w_out = (const float*)d_in[17]; a.g_post = (const float*)d_in[18];
    a.out = (float*)d_out; a.ws = (unsigned char*)d_ws;
    (void)hipMemsetAsync((char*)d_ws + WS_CTL, 0, CTL_BYTES, stream);
#if ONE_LAUNCH
    a.ph_lo = 0; a.ph_hi = 8;
    void* args[] = {&a};
    hipError_t e = hipLaunchCooperativeKernel((const void*)mega, dim3(grid), dim3(512), args, LDS_BYTES, stream);
    if (e != hipSuccess) fprintf(stderr, "kernel_launch: cooperative launch failed: %s (grid %d)\n", hipGetErrorString(e), grid);
#else
    for (int p = 0; p < 8; ++p) { a.ph_lo = p; a.ph_hi = p + 1; hipLaunchKernelGGL(mega, dim3(grid), dim3(512), LDS_BYTES, stream, a); }
#endif
}
```

```cpp
#include <hip/hip_runtime.h>
#include <hip/hip_cooperative_groups.h>
#include <cstdio>
#include <cstdint>
namespace cg = cooperative_groups;

#ifndef ONE_LAUNCH
#define ONE_LAUNCH 1
#endif

#define LAS __attribute__((address_space(3)))
typedef unsigned short bf16_t;
typedef short bf16x8 __attribute__((ext_vector_type(8)));
typedef float f32x4 __attribute__((ext_vector_type(4)));
typedef unsigned u32x4 __attribute__((ext_vector_type(4)));
typedef unsigned u32x2 __attribute__((ext_vector_type(2)));

constexpr int NB = 32, SEQ = 2048, DM = 1024, NTOK = NB * SEQ;
constexpr int POOLW = 384, SSMW = 384, ATTW = 256, INW = 2048;
constexpr int NG = 24, SN = 64, SG = 16;
constexpr int CT = 32, NCH = SEQ / CT, NRC = NB * NCH;
constexpr int UK = CT * SG;
constexpr int UROW = NG * 640 + 64;
constexpr int NMEM = 256, NH = 4, HD = 64;
constexpr float EPS = 1e-6f;

constexpr size_t MB_ = 1024 * 1024;
constexpr size_t WS_HB = 0;
constexpr size_t WS_PROJ = WS_HB + 128 * MB_;
constexpr size_t WS_UBUF = WS_PROJ + 256 * MB_;
constexpr size_t WS_SEND = WS_UBUF + (size_t)NRC * UROW * 2;
constexpr size_t WS_YBUF = WS_SEND + (size_t)NRC * 3072 * 4;
constexpr size_t WS_SSQ = WS_YBUF + (size_t)NTOK * 384 * 2;
constexpr size_t WS_MB = WS_SSQ + (size_t)NTOK * 16 * 4;
constexpr size_t WS_KB = WS_MB + (size_t)8192 * 1024 * 2;
constexpr size_t WS_VT = WS_KB + (size_t)NB * NH * NMEM * HD * 2;
constexpr size_t WS_WIN = WS_VT + (size_t)NB * NH * NMEM * HD * 2;
constexpr size_t WS_WKV = WS_WIN + (size_t)2048 * 1024 * 2;
constexpr size_t WS_WGLU = WS_WKV + (size_t)512 * 1024 * 2;
constexpr size_t WS_WOUT = WS_WGLU + (size_t)768 * 384 * 2;
constexpr size_t WS_BS1 = WS_WOUT + (size_t)1024 * 1024 * 2;
constexpr size_t WS_BS2 = WS_BS1 + (size_t)12 * 256 * 1280 * 2;
constexpr size_t WS_LAMT = WS_BS2 + (size_t)24 * 512 * 640 * 2;
constexpr size_t WS_CTL = WS_LAMT + (size_t)24 * 64 * 2 * 4;
constexpr size_t CTL_BYTES = 16384;
constexpr size_t WS_END = WS_CTL + CTL_BYTES;

constexpr int LDS_BYTES = 147456;

__device__ __forceinline__ unsigned cvt_pk_bf16(float lo, float hi) { unsigned r; asm volatile("v_cvt_pk_bf16_f32 %0, %1, %2" : "=v"(r) : "v"(lo), "v"(hi)); return r; }
__device__ __forceinline__ bf16_t f2bf(float f) { return (bf16_t)(cvt_pk_bf16(f, 0.f) & 0xffffu); }
__device__ __forceinline__ float bf_lo(unsigned w) { return __uint_as_float(w << 16); }
__device__ __forceinline__ float bf_hi(unsigned w) { return __uint_as_float(w & 0xffff0000u); }
__device__ __forceinline__ float sigmoid_f(float v) { return __builtin_amdgcn_rcpf(1.0f + __builtin_amdgcn_exp2f(-1.44269504f * v)); }
__device__ __forceinline__ float silu_f(float v) { return v * sigmoid_f(v); }
__device__ __forceinline__ float gelu_tanh_f(float v) { const float z = 0.7978845608f * (v + 0.044715f * v * v * v); return v * sigmoid_f(2.0f * z); }

namespace pg8 {
constexpr int BM = 256, BK = 64, HALF = 128, HTB = HALF * BK * 2, STAGE_BYTES = 8 * HTB, NXCD = 8, WGM = 8;
__host__ __device__ __forceinline__ int lds_byte(int r, int c) { const int st = (r >> 4) * 2 + (c >> 5), rr = r & 15, cc = c & 31, ob = rr * 64 + cc * 2; return st * 1024 + (ob ^ (((ob >> 9) & 1) << 5)); }
__host__ __device__ __forceinline__ void stage_rc(int b, int& R, int& C) { const int st = b / 1024, sb = b % 1024, swz = sb ^ (((sb >> 9) & 1) << 5); R = (st >> 1) * 16 + swz / 64; C = (st & 1) * 32 + (swz % 64) / 2; }
__host__ __device__ __forceinline__ int perm32(int rho) { const int n = rho >> 4, i = rho & 15; return 8 * (i >> 2) + 4 * n + (i & 3); }

struct Unit { int pm, pn, aux, nt, skat, skby; size_t aoff, boff; };
struct Gemm { const bf16_t* A; const bf16_t* Bt; int lda, ldb, K; };

struct OrderStd {
    int nM, nN, nwg, G, c, ntiles; size_t astep, bstep;
    __device__ void init(int M, int N, int lda, int ldb, int G_, int c_, int K) { ntiles = K / BK; nM = M / BM; nN = N / BM; nwg = nM * nN; G = G_; c = c_; astep = (size_t)BM * lda * 2; bstep = (size_t)BM * ldb * 2; }
    __device__ bool next(int i, Unit& u) const {
        const long L = (long)i * G + c; if (L >= nwg) return false;
        int wgid = (int)L; { const int q = nwg / NXCD, r = nwg % NXCD, xcd = wgid % NXCD, off = wgid / NXCD; wgid = (xcd < r ? xcd * (q + 1) : r * (q + 1) + (xcd - r) * q) + off; }
        const int nig = WGM * nN, gid = wgid / nig, fm = gid * WGM, gsz = (nM - fm) < WGM ? (nM - fm) : WGM;
        u.pm = fm + ((wgid % nig) % gsz); u.pn = (wgid % nig) / gsz; u.aux = 0; u.nt = ntiles; u.skat = 1 << 30; u.skby = 0; u.aoff = (size_t)u.pm * astep; u.boff = (size_t)u.pn * bstep; return true;
    }
};
struct OrderPanel {
    int G, c, ntiles; size_t astep, bstep;
    __device__ bool next(int i, Unit& u) const {
        const int L = c + (i >> 2) * G; if (L >= NTOK / BM) return false;
        u.pm = L; u.pn = i & 3; u.aux = 0; u.nt = ntiles; u.skat = 1 << 30; u.skby = 0; u.aoff = (size_t)u.pm * astep; u.boff = (size_t)u.pn * bstep; return true;
    }
};
struct OrderS1 {
    int G, c;
    __device__ bool next(int i, Unit& u) const {
        const long L = (long)i * G + c; if (L >= 96) return false;
        u.pm = (int)L / 12; u.pn = (int)L % 12; u.aux = 0; u.nt = 16; u.skat = 8; u.skby = 2;
        u.aoff = ((size_t)u.pm * 256 * UROW + (size_t)u.pn * 1280) * 2; u.boff = (size_t)u.pn * 256 * 1280 * 2; return true;
    }
};
struct OrderS2 {
    int G, c;
    __device__ bool next(int i, Unit& u) const {
        const long L = (long)i * G + c; if (L >= 384) return false;
        const int g = (int)L / 16, rem = (int)L % 16; u.pm = rem >> 1; u.pn = (rem & 1) ^ (i & 1); u.aux = g; u.nt = u.pn ? 10 : 6; u.skat = u.pn ? (1 << 30) : 4; u.skby = u.pn ? 0 : 4;
        u.aoff = ((size_t)u.pm * 256 * UROW + (size_t)g * 640) * 2; u.boff = ((size_t)g * 512 + (size_t)u.pn * 256) * 640 * 2; return true;
    }
};

template <class Epi, class Sched>
__device__ __forceinline__ void gemm_phase(LAS unsigned char* lds, const Gemm g, const Sched& S, const Epi& E) {
    const int tid = threadIdx.x, wid = __builtin_amdgcn_readfirstlane(tid >> 6), lane = tid & 63, wr = wid >> 2, wc = wid & 3, fr = lane & 15, fq = lane >> 4;
    unsigned voffA[2], voffB[2];
#pragma unroll
    for (int i = 0; i < 2; ++i) { int R, C; stage_rc(tid * 16 + i * 8192, R, C); const int Rb = Epi::PERM ? ((R & ~31) + perm32(R & 31)) : R;
        voffA[i] = (unsigned)(R * g.lda + C) * 2u; voffB[i] = (unsigned)(Rb * g.ldb + C) * 2u; }
    const size_t kstep = (size_t)(BK * 2);
    const size_t hstepA = (size_t)HALF * g.lda * 2, hstepB = (size_t)HALF * g.ldb * 2;
    const unsigned ldsw = (unsigned)wid * 1024u;
    const int aoff = lds_byte(wr * 64 + fr, fq * 8), boff = lds_byte(wc * 32 + fr, fq * 8);
#define PG8_SA(b, h) (((b) * 2 + (h)) * HTB)
#define PG8_SB(b, h) ((4 + (b) * 2 + (h)) * HTB)
#define PG8_STAGE(bufoff, gbase, voff) do { _Pragma("unroll") for (int _i = 0; _i < 2; ++_i) \
        __builtin_amdgcn_global_load_lds((const unsigned*)((const char*)(gbase) + (voff)[_i]), (LAS unsigned*)(lds + (bufoff) + ldsw + _i * 8192), 16, 0, 0); } while (0)
#define PG8_LDA(dst, b, h) do { _Pragma("unroll") for (int m = 0; m < 4; ++m) _Pragma("unroll") for (int k = 0; k < 2; ++k) dst[m][k] = *(const LAS bf16x8*)(lds + PG8_SA(b, h) + aoff + m * 2048 + k * 1024); } while (0)
#define PG8_LDB(dst, b, h) do { _Pragma("unroll") for (int n = 0; n < 2; ++n) _Pragma("unroll") for (int k = 0; k < 2; ++k) dst[n][k] = *(const LAS bf16x8*)(lds + PG8_SB(b, h) + boff + n * 2048 + k * 1024); } while (0)
#define PG8_MMA(ai, bj, At, Bt) do { __builtin_amdgcn_s_setprio(1); _Pragma("unroll") for (int m = 0; m < 4; ++m) _Pragma("unroll") for (int n = 0; n < 2; ++n) _Pragma("unroll") for (int k = 0; k < 2; ++k) \
        acc[ai][bj][m][n] = __builtin_amdgcn_mfma_f32_16x16x32_bf16(Bt[n][k], At[m][k], acc[ai][bj][m][n], 0, 0, 0); __builtin_amdgcn_s_setprio(0); } while (0)
#define PG8_WAIT_V(n) asm volatile("s_waitcnt vmcnt(" #n ")" ::: "memory")
#define PG8_WAIT_L(n) asm volatile("s_waitcnt lgkmcnt(" #n ")" ::: "memory")
#define PG8_BAR __builtin_amdgcn_s_barrier()
#define PG8_SCHED __builtin_amdgcn_sched_barrier(0)
    Unit cur, nxt; int ui = 0;
    if (!S.next(0, cur)) return;
    int nt = cur.nt;
    f32x4 acc[2][2][4][2];
#pragma unroll
    for (int a = 0; a < 2; ++a)
#pragma unroll
        for (int b = 0; b < 2; ++b)
#pragma unroll
            for (int m = 0; m < 4; ++m)
#pragma unroll
                for (int n = 0; n < 2; ++n) acc[a][b][m][n] = (f32x4){0.f, 0.f, 0.f, 0.f};
    bf16x8 At[4][2], B0[2][2], B1[2][2];
    const char* cA = (const char*)g.A + cur.aoff; const char* cB = (const char*)g.Bt + cur.boff;
    PG8_STAGE(PG8_SB(0, 0), cB, voffB); PG8_STAGE(PG8_SB(0, 1), cB + hstepB, voffB); PG8_STAGE(PG8_SA(0, 0), cA, voffA); PG8_STAGE(PG8_SA(0, 1), cA + hstepA, voffA);
    if (wr == 1) PG8_BAR;
    PG8_WAIT_V(2); PG8_BAR;
    PG8_STAGE(PG8_SB(1, 0), cB + kstep, voffB); PG8_STAGE(PG8_SA(1, 0), cA + kstep, voffA); PG8_STAGE(PG8_SB(1, 1), cB + hstepB + kstep, voffB);
    PG8_WAIT_V(6); PG8_BAR;
    for (;;) {
        const bool has_next = S.next(ui + 1, nxt);
        const char* nA = has_next ? (const char*)g.A + nxt.aoff : cA; const char* nB = has_next ? (const char*)g.Bt + nxt.boff : cB;
#pragma unroll 1
        for (int t = 0; t < nt; t += 2) {
            const bool last = (t == nt - 2);
            const size_t o1 = (size_t)(t + 1 + (t + 1 >= cur.skat ? cur.skby : 0)) * kstep, o2 = (size_t)(t + 2 + (t + 2 >= cur.skat ? cur.skby : 0)) * kstep;
            const char* a1 = cA + o1;
            const char* a2 = last ? nA : cA + o2; const char* b2 = last ? nB : cB + o2;
            const char* a3 = a2 + kstep; const char* b3 = b2 + kstep;
            PG8_LDB(B0, 0, 0); PG8_LDB(B1, 0, 1); PG8_SCHED; PG8_LDA(At, 0, 0); PG8_STAGE(PG8_SA(1, 1), a1 + hstepA, voffA);
            PG8_WAIT_V(8); PG8_WAIT_L(0); PG8_BAR; PG8_MMA(0, 0, At, B0); PG8_MMA(0, 1, At, B1); PG8_BAR; PG8_SCHED;
            PG8_LDA(At, 0, 1); PG8_STAGE(PG8_SB(0, 0), b2, voffB); PG8_STAGE(PG8_SB(0, 1), b2 + hstepB, voffB); PG8_STAGE(PG8_SA(0, 0), a2, voffA);
            PG8_WAIT_V(8); PG8_WAIT_L(0); PG8_BAR; PG8_MMA(1, 0, At, B0); PG8_MMA(1, 1, At, B1); PG8_BAR; PG8_SCHED;
            PG8_LDB(B0, 1, 0); PG8_LDB(B1, 1, 1); PG8_SCHED; PG8_LDA(At, 1, 0); PG8_STAGE(PG8_SA(0, 1), a2 + hstepA, voffA);
            PG8_WAIT_V(8); PG8_WAIT_L(0); PG8_BAR; PG8_MMA(0, 0, At, B0); PG8_MMA(0, 1, At, B1); PG8_BAR; PG8_SCHED;
            PG8_LDA(At, 1, 1); PG8_STAGE(PG8_SB(1, 0), b3, voffB); PG8_STAGE(PG8_SB(1, 1), b3 + hstepB, voffB); PG8_STAGE(PG8_SA(1, 0), a3, voffA);
            PG8_WAIT_V(8); PG8_WAIT_L(0); PG8_BAR; PG8_MMA(1, 0, At, B0); PG8_MMA(1, 1, At, B1); PG8_BAR; PG8_SCHED;
        }
        if (wr == 0) PG8_BAR;
        E(acc, cur, wr, wc, fr, fq);
        if (!has_next) break;
#pragma unroll
        for (int a = 0; a < 2; ++a)
#pragma unroll
            for (int b = 0; b < 2; ++b)
#pragma unroll
                for (int m = 0; m < 4; ++m)
#pragma unroll
                    for (int n = 0; n < 2; ++n) acc[a][b][m][n] = (f32x4){0.f, 0.f, 0.f, 0.f};
        cur = nxt; cA = nA; cB = nB; ++ui; nt = cur.nt;
        if (wr == 1) PG8_BAR;
    }
    PG8_WAIT_V(0);
    PG8_BAR;
#undef PG8_SA
#undef PG8_SB
#undef PG8_STAGE
#undef PG8_LDA
#undef PG8_LDB
#undef PG8_MMA
#undef PG8_WAIT_V
#undef PG8_WAIT_L
#undef PG8_BAR
#undef PG8_SCHED
}

typedef f32x4 Acc[2][2][4][2];
__device__ __forceinline__ u32x4 pack8(f32x4 v0, f32x4 v1) { u32x4 w; w.x = cvt_pk_bf16(v0[0], v0[1]); w.y = cvt_pk_bf16(v0[2], v0[3]); w.z = cvt_pk_bf16(v1[0], v1[1]); w.w = cvt_pk_bf16(v1[2], v1[3]); return w; }

struct EpiIn {
    static constexpr bool PERM = true;
    bf16_t* PROJ; bf16_t* UBUF;
    __device__ __forceinline__ void operator()(const Acc& acc, const Unit& u, int wr, int wc, int fr, int fq) const {
#pragma unroll
        for (int bj = 0; bj < 2; ++bj) {
            const int blk = 2 * u.pn + bj, col0 = 128 * blk + 32 * wc + 8 * fq;
#pragma unroll
            for (int ai = 0; ai < 2; ++ai)
#pragma unroll
                for (int m = 0; m < 4; ++m) {
                    const int row = u.pm * BM + ai * HALF + wr * 64 + m * 16 + fr;
                    f32x4 v0 = acc[ai][bj][m][0], v1 = acc[ai][bj][m][1];
                    if (blk >= 8) {
#pragma unroll
                        for (int j = 0; j < 4; ++j) { v0[j] = silu_f(v0[j]); v1[j] = silu_f(v1[j]); }
                    } else if (blk >= 6) { v0 = v0 * 0.18033688f; v1 = v1 * 0.18033688f; }
                    const u32x4 w = pack8(v0, v1);
                    if (blk >= 3 && blk < 6) { const int cc = col0 - 384, gg = cc >> 4, cin = cc & 15;
                        *(u32x4*)(UBUF + (size_t)(row >> 5) * UROW + gg * 640 + (row & 31) * 16 + cin) = w; }
                    else *(u32x4*)(PROJ + (size_t)row * INW + col0) = w;
                }
        }
    }
};
struct EpiS1 {
    static constexpr bool PERM = false;
    float* SEND;
    __device__ __forceinline__ void operator()(const Acc& acc, const Unit& u, int wr, int wc, int fr, int fq) const {
        const int row0 = u.pm * BM + wr * 64 + fr, col0 = u.pn * BM + wc * 32 + 4 * fq;
#pragma unroll
        for (int ai = 0; ai < 2; ++ai)
#pragma unroll
            for (int m = 0; m < 4; ++m) { float* rowp = SEND + (size_t)(row0 + ai * HALF + m * 16) * 3072 + col0;
#pragma unroll
                for (int bj = 0; bj < 2; ++bj)
#pragma unroll
                    for (int n = 0; n < 2; ++n) *(f32x4*)(rowp + bj * HALF + n * 16) = acc[ai][bj][m][n]; }
    }
};
struct EpiKV {
    static constexpr bool PERM = true;
    bf16_t* KB; bf16_t* VT;
    __device__ __forceinline__ void operator()(const Acc& acc, const Unit& u, int wr, int wc, int fr, int fq) const {
#pragma unroll
        for (int bj = 0; bj < 2; ++bj) {
            const int c0 = 128 * bj + 32 * wc + 8 * fq, hh = c0 >> 6, d0 = c0 & 63;
#pragma unroll
            for (int ai = 0; ai < 2; ++ai)
#pragma unroll
                for (int m = 0; m < 4; ++m) {
                    const int row = u.pm * BM + ai * HALF + wr * 64 + m * 16 + fr, b = row >> 8, mm = row & 255;
                    const f32x4 v0 = acc[ai][bj][m][0], v1 = acc[ai][bj][m][1];
                    bf16_t* dstb = (u.pn == 0) ? KB : VT;
                    *(u32x4*)(dstb + ((size_t)(b * NH + hh) * NMEM + mm) * HD + d0) = pack8(v0, v1);
                }
        }
    }
};
struct EpiS2 {
    static constexpr bool PERM = true;
    bf16_t* YB;
    __device__ __forceinline__ void operator()(const Acc& acc, const Unit& u, int wr, int wc, int fr, int fq) const {
#pragma unroll
        for (int bj = 0; bj < 2; ++bj) {
            const int j0 = u.pn * BM + 128 * bj + 32 * wc + 8 * fq, t = j0 >> 4, cp = j0 & 15;
#pragma unroll
            for (int ai = 0; ai < 2; ++ai)
#pragma unroll
                for (int m = 0; m < 4; ++m) {
                    const int row = u.pm * BM + ai * HALF + wr * 64 + m * 16 + fr;
                    f32x4 v0 = acc[ai][bj][m][0], v1 = acc[ai][bj][m][1];
#pragma unroll
                    for (int j = 0; j < 4; ++j) { v0[j] = gelu_tanh_f(v0[j]); v1[j] = gelu_tanh_f(v1[j]); }
                    *(u32x4*)(YB + ((size_t)row * CT + t) * SSMW + u.aux * SG + cp) = pack8(v0, v1);
                }
        }
    }
};
struct EpiGlu {
    static constexpr bool PERM = true;
    const bf16_t* PROJ; bf16_t* GB;
    __device__ __forceinline__ void operator()(const Acc& acc, const Unit& u, int wr, int wc, int fr, int fq) const {
        const int jj0 = (u.pn * BM + 32 * wc + 8 * fq) >> 1;
        const unsigned row0 = (unsigned)(u.pm * BM + wr * 64 + fr);
        const unsigned goff0 = (row0 * INW + 1024 + 384 + jj0) * 2u, ooff0 = (row0 * DM + 384 + jj0) * 2u;
        u32x2 sgv[2][4][2];
#pragma unroll
        for (int ai = 0; ai < 2; ++ai)
#pragma unroll
            for (int m = 0; m < 4; ++m)
#pragma unroll
                for (int bj = 0; bj < 2; ++bj) sgv[ai][m][bj] = *(const u32x2*)((const char*)PROJ + (goff0 + (unsigned)(ai * HALF + m * 16) * INW * 2u + 128u * bj));
        asm volatile("" ::: "memory");
#pragma unroll
        for (int ai = 0; ai < 2; ++ai)
#pragma unroll
            for (int m = 0; m < 4; ++m) {
                const unsigned ooff = ooff0 + (unsigned)(ai * HALF + m * 16) * DM * 2u;
#pragma unroll
                for (int bj = 0; bj < 2; ++bj) {
                    const f32x4 z1 = acc[ai][bj][m][0], z2 = acc[ai][bj][m][1];
                    const u32x2 sg = sgv[ai][m][bj];
                    const float o0 = z1[0] * sigmoid_f(z2[0]) * bf_lo(sg.x), o1 = z1[1] * sigmoid_f(z2[1]) * bf_hi(sg.x);
                    const float o2 = z1[2] * sigmoid_f(z2[2]) * bf_lo(sg.y), o3 = z1[3] * sigmoid_f(z2[3]) * bf_hi(sg.y);
                    u32x2 w; w.x = cvt_pk_bf16(o0, o1); w.y = cvt_pk_bf16(o2, o3);
                    *(u32x2*)((char*)GB + (ooff + 128u * bj)) = w;
                }
            }
    }
};
struct EpiOut {
    static constexpr bool PERM = true;
    bf16_t* OB; float* SSQ;
    __device__ __forceinline__ void operator()(const Acc& acc, const Unit& u, int wr, int wc, int fr, int fq) const {
#pragma unroll
        for (int ai = 0; ai < 2; ++ai)
#pragma unroll
            for (int m = 0; m < 4; ++m) {
                const int row = u.pm * BM + ai * HALF + wr * 64 + m * 16 + fr;
                float s = 0.f;
#pragma unroll
                for (int bj = 0; bj < 2; ++bj) {
                    const int col0 = u.pn * BM + 128 * bj + 32 * wc + 8 * fq;
                    const f32x4 v0 = acc[ai][bj][m][0], v1 = acc[ai][bj][m][1];
                    s += (v0[0] * v0[0] + v0[1] * v0[1]) + (v0[2] * v0[2] + v0[3] * v0[3]) + (v1[0] * v1[0] + v1[1] * v1[1]) + (v1[2] * v1[2] + v1[3] * v1[3]);
                    *(u32x4*)(OB + (size_t)row * DM + col0) = pack8(v0, v1);
                }
                s += __shfl_xor(s, 16); s += __shfl_xor(s, 32);
                if (fq == 0) SSQ[(size_t)row * 16 + u.pn * 4 + wc] = s;
            }
    }
};
}


#define XB_TMO      128
#define XB_XCNT(j)  (256  + 64 * (j))
#define XB_XSUB(j)  (1280 + 64 * (j))
#define XB_XGEN(j)  (2304 + 64 * (j))
#define XB_TOP      3328
#define XB_TOPGEN   3392
#define XCD_BAR_WORDS 3456
#define XB_SPIN_CAP (1u << 18)
__device__ __forceinline__ unsigned xb_ld(unsigned* p)              { return __hip_atomic_load(p, __ATOMIC_RELAXED, __HIP_MEMORY_SCOPE_AGENT); }
__device__ __forceinline__ unsigned xb_add(unsigned* p, unsigned v) { return __hip_atomic_fetch_add(p, v, __ATOMIC_RELAXED, __HIP_MEMORY_SCOPE_AGENT); }
__device__ __forceinline__ unsigned xb_xcc_id() { return (unsigned)__builtin_amdgcn_s_getreg((3 << 11) | 20) & 0xFu; }
#define XB_SPIN(cond, bar) do { unsigned _sp = 0; while (cond) { __builtin_amdgcn_s_sleep(1); \
    if ((++_sp & 255u) == 0u) { if (xb_ld(&(bar)[XB_TMO])) break; if (_sp > XB_SPIN_CAP) { atomicAdd(&(bar)[XB_TMO], 1u); break; } } } } while (0)
struct XcdBarrier { unsigned* bar; unsigned x; volatile LAS unsigned* st; };
__device__ __forceinline__ XcdBarrier xcd_barrier_post(unsigned* bar, volatile LAS unsigned* st) {
    XcdBarrier b; b.bar = bar; b.x = xb_xcc_id(); b.st = st;
    if (threadIdx.x == 0) (void)xb_add(&bar[XB_XCNT(b.x)], 1u);
    return b;
}
__device__ __forceinline__ void xcd_barrier_complete(unsigned* bar, unsigned x, unsigned& nloc, unsigned& nx) {
    const unsigned G = gridDim.x * gridDim.y * gridDim.z;
    unsigned sum, cnt, mine, sp = 0u;
    for (;;) {
        sum = 0u; cnt = 0u; mine = 0u;
#pragma unroll
        for (unsigned j = 0; j < 16; ++j) { const unsigned c = xb_ld(&bar[XB_XCNT(j)]); sum += c; cnt += (c > 0u) ? 1u : 0u; mine = (j == x) ? c : mine; }
        if (sum == G) break;
        __builtin_amdgcn_s_sleep(1);
        if ((++sp & 255u) == 0u) { if (xb_ld(&bar[XB_TMO])) break; if (sp > XB_SPIN_CAP) { atomicAdd(&bar[XB_TMO], 1u); break; } }
    }
    nloc = mine > 0u ? mine : 1u; nx = cnt > 0u ? cnt : 1u;
}
__device__ __forceinline__ void xcd_barrier(const XcdBarrier& b) {
    asm volatile("s_waitcnt vmcnt(0)" ::: "memory");
    __syncthreads();
    if (threadIdx.x == 0) {
        unsigned* bar = b.bar;
        __builtin_amdgcn_s_waitcnt(0);
        unsigned nloc = b.st[0], nx = b.st[1];
        if (nloc == 0u) { xcd_barrier_complete(bar, b.x, nloc, nx); b.st[0] = nloc; b.st[1] = nx; }
        const unsigned old = xb_add(&bar[XB_XSUB(b.x)], 1u);
        const unsigned gen = old / nloc;
        if (old + 1u == (gen + 1u) * nloc) {
            __builtin_amdgcn_fence(__ATOMIC_RELEASE, "agent");
            asm volatile("s_waitcnt vmcnt(0)" ::: "memory");
            const unsigned og = xb_add(&bar[XB_TOP], 1u);
            const unsigned tg = og / nx;
            if (og + 1u == (tg + 1u) * nx) xb_add(&bar[XB_TOPGEN], 1u);
            else XB_SPIN(xb_ld(&bar[XB_TOPGEN]) == tg, bar);
            __builtin_amdgcn_fence(__ATOMIC_ACQUIRE, "agent");
            xb_add(&bar[XB_XGEN(b.x)], 1u);
            asm volatile("s_waitcnt vmcnt(0)" ::: "memory");
        } else {
            XB_SPIN(xb_ld(&bar[XB_XGEN(b.x)]) == gen, bar);
            __builtin_amdgcn_fence(__ATOMIC_ACQUIRE, "agent");
            asm volatile("s_waitcnt vmcnt(0)" ::: "memory");
        }
    }
    __syncthreads();
}

struct Args {
    const float* x; const float* mem; const float* g_pre; const float* w_in; const float* w_pool; const float* pool_scale;
    const float* a_re; const float* a_im; const float* log_dt; const float* b_re; const float* b_im; const float* c_re; const float* c_im;
    const float* d_skip; const float* w_glu; const float* g_mem; const float* w_kv; const float* w_out; const float* g_post;
    float* out; unsigned char* ws; int ph_lo, ph_hi;
};

__device__ __forceinline__ float wave_sum(float v) {
    v += __shfl_xor(v, 32); v += __shfl_xor(v, 16); v += __shfl_xor(v, 8); v += __shfl_xor(v, 4); v += __shfl_xor(v, 2); v += __shfl_xor(v, 1); return v;
}

__device__ __forceinline__ void rmsnorm_rows(const float* src, const float* g, bf16_t* dst, int nrows, int gwave, int nwaves, int lane) {
    int row = 2 * gwave;
    if (row >= nrows) return;
    f32x4 v0[4], v1[4];
    { const f32x4* p0 = (const f32x4*)(src + (size_t)row * DM); const f32x4* p1 = p0 + DM / 4;
#pragma unroll
      for (int i = 0; i < 4; ++i) { v0[i] = __builtin_nontemporal_load(p0 + lane + 64 * i); v1[i] = __builtin_nontemporal_load(p1 + lane + 64 * i); } }
    f32x4 gv[4];
#pragma unroll
    for (int i = 0; i < 4; ++i) gv[i] = ((const f32x4*)g)[lane + 64 * i];
    for (;;) {
        const int nrow = row + 2 * nwaves; const bool more = nrow < nrows;
        f32x4 n0[4], n1[4];
        if (more) { const f32x4* p0 = (const f32x4*)(src + (size_t)nrow * DM); const f32x4* p1 = p0 + DM / 4;
#pragma unroll
            for (int i = 0; i < 4; ++i) { n0[i] = __builtin_nontemporal_load(p0 + lane + 64 * i); n1[i] = __builtin_nontemporal_load(p1 + lane + 64 * i); } }
        float ss0 = 0.f, ss1 = 0.f;
#pragma unroll
        for (int i = 0; i < 4; ++i) { ss0 += (v0[i][0] * v0[i][0] + v0[i][1] * v0[i][1]) + (v0[i][2] * v0[i][2] + v0[i][3] * v0[i][3]);
                                      ss1 += (v1[i][0] * v1[i][0] + v1[i][1] * v1[i][1]) + (v1[i][2] * v1[i][2] + v1[i][3] * v1[i][3]); }
        ss0 = wave_sum(ss0); ss1 = wave_sum(ss1);
        const float rs0 = rsqrtf(ss0 * (1.0f / DM) + EPS), rs1 = rsqrtf(ss1 * (1.0f / DM) + EPS);
#pragma unroll
        for (int i = 0; i < 4; ++i) {
            u32x2 w; w.x = cvt_pk_bf16(v0[i][0] * rs0 * gv[i][0], v0[i][1] * rs0 * gv[i][1]); w.y = cvt_pk_bf16(v0[i][2] * rs0 * gv[i][2], v0[i][3] * rs0 * gv[i][3]);
            *(u32x2*)(dst + (size_t)row * DM + 4 * (lane + 64 * i)) = w;
            w.x = cvt_pk_bf16(v1[i][0] * rs1 * gv[i][0], v1[i][1] * rs1 * gv[i][1]); w.y = cvt_pk_bf16(v1[i][2] * rs1 * gv[i][2], v1[i][3] * rs1 * gv[i][3]);
            *(u32x2*)(dst + (size_t)(row + 1) * DM + 4 * (lane + 64 * i)) = w; }
        if (!more) break;
#pragma unroll
        for (int i = 0; i < 4; ++i) { v0[i] = n0[i]; v1[i] = n1[i]; }
        row = nrow;
    }
}

template <int MODE>
__device__ __forceinline__ void tr_tile(const float* src, int ld_src, int k0, int n0, bf16_t* dst, int ld_dst, LAS float* tile, int tid) {
    __syncthreads();
    for (int e = tid; e < 4096; e += 512) { const int kk = e >> 6, nn = e & 63; tile[kk * 65 + nn] = src[(size_t)(k0 + kk) * ld_src + n0 + nn]; }
    __syncthreads();
    for (int e = tid; e < 4096; e += 512) { const int nn = e >> 6, kk = e & 63; int n = n0 + nn;
        if (MODE == 1) { n = (n < 384) ? (8 * (n >> 2) + (n & 3)) : (8 * ((n - 384) >> 2) + 4 + ((n - 384) & 3)); }
        dst[(size_t)n * ld_dst + k0 + kk] = f2bf(tile[kk * 65 + nn]); }
}

template <int W>
__device__ __forceinline__ void pool_seg(const bf16_t* PROJ, bf16_t* GBUF, int b, int t0, int cgp) {
    const bf16_t* zb = PROJ + ((size_t)b * SEQ + t0) * INW + 8 * cgp;
    bf16_t* ob = GBUF + ((size_t)b * SEQ + t0) * DM + 8 * cgp;
    u32x4 hist[W - 1], zc[8], gc[8], nz[8], ng[8];
#pragma unroll
    for (int i = 0; i < W - 1; ++i) hist[i] = (t0 > 0) ? *(const u32x4*)(zb - (size_t)(i + 1) * INW) : (u32x4){0u, 0u, 0u, 0u};
#pragma unroll
    for (int d = 0; d < 8; ++d) { zc[d] = *(const u32x4*)(zb + (size_t)d * INW); gc[d] = *(const u32x4*)(zb + (size_t)d * INW + 1024); }
    float S[8];
#pragma unroll
    for (int q = 0; q < 8; ++q) S[q] = 0.f;
#pragma unroll
    for (int i = 0; i < W - 1; ++i) { const u32x4 v = hist[i];
        S[0] += bf_lo(v.x); S[1] += bf_hi(v.x); S[2] += bf_lo(v.y); S[3] += bf_hi(v.y); S[4] += bf_lo(v.z); S[5] += bf_hi(v.z); S[6] += bf_lo(v.w); S[7] += bf_hi(v.w); }
#pragma unroll 1
    for (int sr = 0; sr < 4; ++sr) {
        if (sr < 3) {
#pragma unroll
            for (int d = 0; d < 8; ++d) { nz[d] = *(const u32x4*)(zb + (size_t)(8 * (sr + 1) + d) * INW); ng[d] = *(const u32x4*)(zb + (size_t)(8 * (sr + 1) + d) * INW + 1024); }
        }
#pragma unroll
        for (int d = 0; d < 8; ++d) {
            const u32x4 v = zc[d], gv = gc[d];
            const float z[8] = {bf_lo(v.x), bf_hi(v.x), bf_lo(v.y), bf_hi(v.y), bf_lo(v.z), bf_hi(v.z), bf_lo(v.w), bf_hi(v.w)};
            const float sg[8] = {bf_lo(gv.x), bf_hi(gv.x), bf_lo(gv.y), bf_hi(gv.y), bf_lo(gv.z), bf_hi(gv.z), bf_lo(gv.w), bf_hi(gv.w)};
            const int tt = t0 + 8 * sr + d + 1; const float inv = 1.0f / (float)(tt < W ? tt : W);
            float o[8];
#pragma unroll
            for (int q = 0; q < 8; ++q) { S[q] += z[q]; o[q] = (S[q] * inv - z[q]) * sg[q]; }
            u32x4 wv; wv.x = cvt_pk_bf16(o[0], o[1]); wv.y = cvt_pk_bf16(o[2], o[3]); wv.z = cvt_pk_bf16(o[4], o[5]); wv.w = cvt_pk_bf16(o[6], o[7]);
            *(u32x4*)(ob + (size_t)(8 * sr + d) * DM) = wv;
            const u32x4 r = (d - W + 1 >= 0) ? zc[(d - W + 1 >= 0) ? (d - W + 1) : 0] : hist[(W - 2 - d >= 0) ? (W - 2 - d) : 0];
            S[0] -= bf_lo(r.x); S[1] -= bf_hi(r.x); S[2] -= bf_lo(r.y); S[3] -= bf_hi(r.y); S[4] -= bf_lo(r.z); S[5] -= bf_hi(r.z); S[6] -= bf_lo(r.w); S[7] -= bf_hi(r.w);
        }
        u32x4 nh[W - 1];
#pragma unroll
        for (int i = 0; i < W - 1; ++i) nh[i] = (i < 8) ? zc[(i < 8) ? (7 - i) : 0] : hist[(i >= 8) ? (i - 8) : 0];
#pragma unroll
        for (int i = 0; i < W - 1; ++i) hist[i] = nh[i];
#pragma unroll
        for (int d = 0; d < 8; ++d) { zc[d] = nz[d]; gc[d] = ng[d]; }
    }
}
__device__ __forceinline__ void pool_item(unsigned char* ws, int id, int tid) {
    const bf16_t* PROJ = (const bf16_t*)(ws + WS_PROJ); bf16_t* GBUF = (bf16_t*)(ws + WS_HB);
    const int b = id >> 3, gi = (id >> 1) & 3, seg = tid / 12, cgp = gi * 12 + (tid - seg * 12), t0 = (id & 1) * 1024 + seg * 32;
    if (seg < 32) {
        if (gi == 0) pool_seg<2>(PROJ, GBUF, b, t0, cgp);
        else if (gi == 1) pool_seg<4>(PROJ, GBUF, b, t0, cgp);
        else if (gi == 2) pool_seg<8>(PROJ, GBUF, b, t0, cgp);
        else pool_seg<16>(PROJ, GBUF, b, t0, cgp);
    }
}
#define QW(k) ((unsigned*)(a.ws + WS_CTL) + 3520 + 64 * (k))

__global__ void __launch_bounds__(512, 2) mega(Args a) {
    extern __shared__ __attribute__((aligned(16))) unsigned char lds_raw[];
    LAS unsigned char* lds = (LAS unsigned char*)lds_raw;
    const int G = gridDim.x, bid = blockIdx.x;
#define TIDS int tid = threadIdx.x; asm volatile("" : "+v"(tid)); const int lane = tid & 63, wave = tid >> 6; (void)lane; (void)wave
#define WSP unsigned char* ws = a.ws; asm volatile("" : "+s"(ws))
#define HB ((bf16_t*)(ws + WS_HB))
#define GBUF ((bf16_t*)(ws + WS_HB))
#define PROJ ((bf16_t*)(ws + WS_PROJ))
#define OBUF ((bf16_t*)(ws + WS_PROJ))
#define UBUF ((bf16_t*)(ws + WS_UBUF))
#define SEND ((float*)(ws + WS_SEND))
#define YBUF ((bf16_t*)(ws + WS_YBUF))
#define SSQ ((float*)(ws + WS_SSQ))
#define MBF ((bf16_t*)(ws + WS_MB))
#define KB ((bf16_t*)(ws + WS_KB))
#define VT ((bf16_t*)(ws + WS_VT))
#define WIN ((bf16_t*)(ws + WS_WIN))
#define WKV ((bf16_t*)(ws + WS_WKV))
#define WGLU ((bf16_t*)(ws + WS_WGLU))
#define WOUT ((bf16_t*)(ws + WS_WOUT))
#define BS1 ((bf16_t*)(ws + WS_BS1))
#define BS2 ((bf16_t*)(ws + WS_BS2))
#define LAMT ((float*)(ws + WS_LAMT))
    const int lo = a.ph_lo, hi = a.ph_hi;
    if (threadIdx.x < 4) ((LAS unsigned*)(lds + 131072))[threadIdx.x] = 0u;
    __syncthreads();
    XcdBarrier gbar; gbar.bar = (unsigned*)(a.ws + WS_CTL); gbar.x = 0; gbar.st = (volatile LAS unsigned*)(lds + 131072);
    if (hi - lo > 1) gbar = xcd_barrier_post((unsigned*)(a.ws + WS_CTL), (volatile LAS unsigned*)(lds + 131072));
    if (hi > 8) cg::this_grid().sync();
#ifdef PROBE_TS
#define STAMP(j) do { if (blockIdx.x == 0 && threadIdx.x == 0) ((volatile LAS unsigned long long*)(lds + 131072 + 64))[j] = __builtin_amdgcn_s_memrealtime(); } while (0)
#else
#define STAMP(j) do {} while (0)
#endif
    STAMP(0);
#ifndef PH_MASK
#define PH_MASK 0xff
#endif
#ifndef PROBE_MASK
#define PROBE_MASK 0
#endif
#define IN(k) (((PH_MASK >> (k)) & 1) && lo <= (k) && (k) < hi)
#define REPS(k) for (int rep_ = 0; rep_ < (((PROBE_MASK >> (k)) & 1) ? 2 : 1); ++rep_)
#define SEAM(k) do { if (IN(k) && IN((k) + 1)) { xcd_barrier(gbar); } } while (0)

    if (IN(0)) REPS(0) {
        WSP;
        TIDS;
        LAS float* sm = (LAS float*)lds;
        constexpr int N_SSM = NG * CT, N_TRIN = 26 * 16, N_TROUT = 256, N_TRGLU = 72, N_TRKV = 128, N_FOLD = 64;
        constexpr int I1 = N_SSM, I2 = I1 + N_TRIN, I3 = I2 + N_TROUT, I4 = I3 + N_TRGLU, I5 = I4 + N_TRKV, I6 = I5 + N_FOLD;
#ifdef PROBE_ITEMS
        for (int rp_ = 0; rp_ < 2; ++rp_)
#endif
        for (int item = bid; item < I6; item += G) {
            if (item < I1) {
                const int g = item / CT, j = item % CT;
                LAS float* sBr = sm + 512; LAS float* sBi = sm + 1536; LAS float* sCr = sm + 2560; LAS float* sCi = sm + 3616;
                __syncthreads();
#pragma unroll
                for (int r = 0; r < 2; ++r) { const int idx = tid + 512 * r;
                    sBr[idx] = a.b_re[(size_t)g * 1024 + idx]; sBi[idx] = a.b_im[(size_t)g * 1024 + idx];
                    sCr[(idx >> 6) * 65 + (idx & 63)] = a.c_re[(size_t)g * 1024 + idx]; sCi[(idx >> 6) * 65 + (idx & 63)] = a.c_im[(size_t)g * 1024 + idx]; }
                if (tid < 64) {
                    const int n = tid; const float ar = a.a_re[g * SN + n], ai = a.a_im[g * SN + n], dt = expf(a.log_dt[g]);
                    const float xr = ar * dt, yi = ai * dt;
                    float s0, c0, s1, c1, sy, cy;
                    const float m0 = expf((float)j * xr); sincosf((float)j * yi, &s0, &c0);
                    const float m1 = expf((float)(j + 1) * xr); sincosf((float)(j + 1) * yi, &s1, &c1);
                    const float e1 = expm1f(xr); sincosf(yi, &sy, &cy); const float sh = sinf(0.5f * yi);
                    const float br = e1 * cy - 2.f * sh * sh, bi = (e1 + 1.f) * sy;
                    const float den = 1.f / (ar * ar + ai * ai);
                    const float cr = (br * ar + bi * ai) * den, ci = (bi * ar - br * ai) * den;
                    const float ljr = m0 * c0, lji = m0 * s0;
                    sm[n] = ljr; sm[64 + n] = lji; sm[128 + n] = m1 * c1; sm[192 + n] = m1 * s1;
                    sm[256 + n] = ljr * cr - lji * ci; sm[320 + n] = ljr * ci + lji * cr;
                    if (j == CT - 1) { LAMT[(g * SN + n) * 2] = m1 * c1; LAMT[(g * SN + n) * 2 + 1] = m1 * s1; }
                }
                __syncthreads();
                bf16_t* bs2 = BS2 + (size_t)g * 512 * 640;
                if (tid < 256) {
                    const int cp = tid >> 4, c = tid & 15; float kv = 0.f;
                    for (int n = 0; n < SN; ++n) {
                        const float Br = sBr[n * SG + c], Bi = sBi[n * SG + c];
                        const float Cr = sCr[cp * 65 + n], Ci = sCi[cp * 65 + n];
                        const float lr = sm[256 + n], li = sm[320 + n];
                        const float pr = lr * Br - li * Bi, pi = lr * Bi + li * Br;
                        kv += Cr * pr - Ci * pi;
                    }
                    if (j == 0 && c == cp) kv += a.d_skip[g * SG + cp];
                    const bf16_t kb = f2bf(kv);
                    for (int t = j; t < CT; ++t) { const int s = t - j;
                        bs2[(size_t)(t * SG + cp) * 640 + s * SG + c] = kb;
                        if (j > 0) bs2[(size_t)(s * SG + cp) * 640 + t * SG + c] = 0; }
                } else {
#pragma unroll
                    for (int r = 0; r < 4; ++r) { const int idx = (tid - 256) + 256 * r, cp = idx >> 6, n = idx & 63;
                        const float Cr = sCr[cp * 65 + n], Ci = sCi[cp * 65 + n];
                        const float lr = sm[128 + n], li = sm[192 + n];
                        bs2[(size_t)(j * SG + cp) * 640 + 512 + n] = f2bf(Cr * lr - Ci * li);
                        bs2[(size_t)(j * SG + cp) * 640 + 576 + n] = f2bf(-(Cr * li + Ci * lr)); }
                }
                {
                    const int s = CT - 1 - j, p = g >> 1, gl = g & 1;
                    bf16_t* bs1 = BS1 + (size_t)p * 256 * 1280;
#pragma unroll
                    for (int r = 0; r < 2; ++r) { const int idx = tid + 512 * r, n = idx >> 4, c = idx & 15;
                        const float Br = sBr[n * SG + c], Bi = sBi[n * SG + c];
                        const float lr = sm[256 + n], li = sm[320 + n];
                        bs1[(size_t)(gl * 128 + n) * 1280 + gl * 640 + s * SG + c] = f2bf(lr * Br - li * Bi);
                        bs1[(size_t)(gl * 128 + 64 + n) * 1280 + gl * 640 + s * SG + c] = f2bf(lr * Bi + li * Br); }
                    for (int idx = tid; idx < 128 * 24; idx += 512) { const int rr = idx / 24, q = idx % 24; int col;
                        if (q < 16) col = (1 - gl) * 640 + s * SG + q; else if (q < 20) col = gl * 640 + 512 + 4 * s + (q - 16); else col = (1 - gl) * 640 + 512 + 4 * s + (q - 20);
                        bs1[(size_t)(gl * 128 + rr) * 1280 + col] = 0; }
                }
            } else if (item < I2) { const int it = item - I1, ntl = it / 16, kt = it % 16; tr_tile<0>(a.w_in, INW, 64 * kt, 384 + 64 * ntl, WIN, DM, sm, tid); }
            else if (item < I3) { const int it = item - I2, ntl = it / 16, kt = it % 16; tr_tile<0>(a.w_out, DM, 64 * kt, 64 * ntl, WOUT, DM, sm, tid); }
            else if (item < I4) { const int it = item - I3, ntl = it / 6, kt = it % 6; tr_tile<1>(a.w_glu, 768, 64 * kt, 64 * ntl, WGLU, 384, sm, tid); }
            else if (item < I5) { const int it = item - I4, ntl = it / 16, kt = it % 16; tr_tile<0>(a.w_kv, 512, 64 * kt, 64 * ntl, WKV, DM, sm, tid); }
            else {
                const int it = item - I5, kt = it >> 2, gi = it & 3, k0 = 64 * kt;
                LAS float* At = sm; LAS float* Wp = sm + 64 * 97;
                __syncthreads();
                for (int e = tid; e < 64 * 96; e += 512) { const int kk = e / 96, c = e % 96; At[kk * 97 + c] = a.w_in[(size_t)(k0 + kk) * INW + gi * 96 + c]; }
                for (int e = tid; e < 96 * 96; e += 512) Wp[e] = a.w_pool[(size_t)gi * 9216 + e];
                __syncthreads();
                const int kk = tid & 63, d0 = (tid >> 6) * 12;
                float ac[12];
#pragma unroll
                for (int i = 0; i < 12; ++i) ac[i] = 0.f;
                for (int c = 0; c < 96; ++c) { const float av = At[kk * 97 + c];
#pragma unroll
                    for (int i = 0; i < 12; ++i) ac[i] += av * Wp[c * 96 + d0 + i]; }
#pragma unroll
                for (int i = 0; i < 12; ++i) { const int d = gi * 96 + d0 + i; WIN[(size_t)d * DM + k0 + kk] = f2bf(ac[i] * a.pool_scale[d]); }
            }
        }
        rmsnorm_rows(a.mem, a.g_mem, MBF, NB * NMEM, bid * 8 + wave, G * 8, lane);
        rmsnorm_rows(a.x, a.g_pre, HB, NTOK, bid * 8 + wave, G * 8, lane);
    }
    SEAM(0); STAMP(1);

    if (IN(1)) REPS(1) {
        WSP;
        pg8::Gemm g{HB, WIN, DM, DM, DM}; pg8::OrderStd S; S.init(NTOK, INW, DM, DM, G, bid, DM);
        pg8::EpiIn E{PROJ, UBUF};
        pg8::gemm_phase<pg8::EpiIn, pg8::OrderStd>(lds, g, S, E);
    }
    SEAM(1); STAMP(2);

    if (IN(2)) REPS(2) {
        WSP;
        { pg8::Gemm g{UBUF, BS1, UROW, 1280, 1280}; pg8::OrderS1 S{G, bid}; pg8::EpiS1 E{SEND};
          pg8::gemm_phase<pg8::EpiS1, pg8::OrderS1>(lds, g, S, E); }
        STAMP(7);
        {
            TIDS;
            asm volatile("s_waitcnt vmcnt(0)" ::: "memory"); __syncthreads();
            for (int L = bid; L < 96; L += G) {
                const int pm = L / 12, p = L % 12, b = 4 * pm + (tid >> 7), g = 2 * p + ((tid >> 6) & 1), n = tid & 63;
                const float lr = LAMT[(g * SN + n) * 2], li = LAMT[(g * SN + n) * 2 + 1];
                float hr = 0.f, hi2 = 0.f;
                for (int k0 = 0; k0 < NCH; k0 += 16) {
                    float sr[16], si[16];
#pragma unroll
                    for (int k = 0; k < 16; ++k) { const size_t row = (size_t)b * NCH + k0 + k; sr[k] = SEND[row * 3072 + g * 128 + n]; si[k] = SEND[row * 3072 + g * 128 + 64 + n]; }
#pragma unroll
                    for (int k = 0; k < 16; ++k) {
                        const size_t row = (size_t)b * NCH + k0 + k;
                        UBUF[row * UROW + g * 640 + 512 + n] = f2bf(hr); UBUF[row * UROW + g * 640 + 576 + n] = f2bf(hi2);
                        const float nr = lr * hr - li * hi2 + sr[k], ni = lr * hi2 + li * hr + si[k]; hr = nr; hi2 = ni;
                    }
                }
            }
        }
        STAMP(8);
        { pg8::Gemm g{MBF, WKV, DM, DM, DM}; pg8::OrderStd S; S.init(NB * NMEM, 512, DM, DM, G, (bid + 160) % G, DM); pg8::EpiKV E{KB, VT};
          pg8::gemm_phase<pg8::EpiKV, pg8::OrderStd>(lds, g, S, E); }
        { TIDS;
        { volatile LAS int* slot = (volatile LAS int*)(lds + 131072 + 16);
          for (;;) {
              __syncthreads();
              if (tid == 0) { const unsigned v = __hip_atomic_fetch_add(QW(0), 1u, __ATOMIC_RELAXED, __HIP_MEMORY_SCOPE_AGENT); *slot = (v < 256u) ? (int)v : -1; }
              __syncthreads();
              const int id = *slot;
              if (id < 0) break;
              pool_item(a.ws, id, tid);
          } }
        }
        STAMP(9);
    }
    SEAM(2); STAMP(3);

    if (IN(4)) REPS(4) {
        WSP;
        { pg8::Gemm g{UBUF, BS2, UROW, 640, 640}; pg8::OrderS2 S{G, bid}; pg8::EpiS2 E{YBUF};
          pg8::gemm_phase<pg8::EpiS2, pg8::OrderS2>(lds, g, S, E); }
        TIDS;
        { volatile LAS int* slot = (volatile LAS int*)(lds + 131072 + 16);
          for (;;) {
              __syncthreads();
              if (tid == 0) { const unsigned v = __hip_atomic_fetch_add(QW(0), 1u, __ATOMIC_RELAXED, __HIP_MEMORY_SCOPE_AGENT); *slot = (v < 256u) ? (int)v : -1; }
              __syncthreads();
              const int id = *slot;
              if (id < 0) break;
              pool_item(a.ws, id, tid);
          } }
    }
    SEAM(4); STAMP(4);

    if (IN(5)) REPS(5) {
        WSP;
#ifndef NO_GLU
        { pg8::Gemm g{YBUF, WGLU, SSMW, SSMW, SSMW}; pg8::OrderStd S; S.init(NTOK, 768, SSMW, SSMW, G, bid, SSMW); pg8::EpiGlu E{PROJ, GBUF};
          pg8::gemm_phase<pg8::EpiGlu, pg8::OrderStd>(lds, g, S, E); }
#endif
#ifndef NO_ATT
        TIDS;
        constexpr int VOFF = 256 * 160;
        const int fr = lane & 15, fq = lane >> 4;
#ifdef PROBE_ATT
        for (int rp_ = 0; rp_ < 2; ++rp_)
#endif
        for (int item = bid; item < NB * 4 * NH; item += G) {
            const int b = item >> 4, rem = item & 15, h = rem & 3, qt = rem >> 2;
            const bf16_t* Kg = KB + (size_t)(b * NH + h) * NMEM * HD; const bf16_t* Vg = VT + (size_t)(b * NH + h) * NMEM * HD;
            const size_t tok0 = (size_t)b * SEQ + qt * 512 + wave * 16 + fr;
            bf16x8 qall[4][2]; u32x2 gall[4][4];
#pragma unroll
            for (int pass = 0; pass < 4; ++pass) {
#pragma unroll
                for (int kk = 0; kk < 2; ++kk) qall[pass][kk] = *(const bf16x8*)(PROJ + (tok0 + pass * 128) * INW + 768 + h * HD + 32 * kk + 8 * fq);
#pragma unroll
                for (int dt = 0; dt < 4; ++dt) gall[pass][dt] = *(const u32x2*)(PROJ + (tok0 + pass * 128) * INW + 1024 + 768 + h * HD + 16 * dt + 4 * fq);
            }
            __syncthreads();
            for (int e = tid; e < 2048; e += 512) { const int m = e >> 3, dc = e & 7; const u32x4 v = *(const u32x4*)(Kg + m * HD + dc * 8);
                const int slot = (m & ~31) + 16 * ((m >> 2) & 1) + 4 * ((m >> 3) & 3) + (m & 3);
                *(LAS u32x4*)(lds + slot * 160 + dc * 16) = v; }
            for (int e = tid; e < 2048; e += 512) { const int m = e >> 3, dc = e & 7; const u32x4 v = *(const u32x4*)(Vg + m * HD + dc * 8);
                LAS unsigned short* vp = (LAS unsigned short*)(lds + VOFF + (dc * 8) * 544 + m * 2);
                vp[0 * 272] = (unsigned short)(v.x & 0xffffu); vp[1 * 272] = (unsigned short)(v.x >> 16); vp[2 * 272] = (unsigned short)(v.y & 0xffffu); vp[3 * 272] = (unsigned short)(v.y >> 16);
                vp[4 * 272] = (unsigned short)(v.z & 0xffffu); vp[5 * 272] = (unsigned short)(v.z >> 16); vp[6 * 272] = (unsigned short)(v.w & 0xffffu); vp[7 * 272] = (unsigned short)(v.w >> 16); }
            __syncthreads();
#pragma unroll
            for (int pass = 0; pass < 4; ++pass) {
            const size_t token = tok0 + pass * 128;
            bf16x8 qf[2];
#pragma unroll
            for (int kk = 0; kk < 2; ++kk) qf[kk] = qall[pass][kk];
            f32x4 s[8][2];
            float mx = -3.0e38f;
#pragma unroll
            for (int blk = 0; blk < 8; ++blk)
#pragma unroll
                for (int sub = 0; sub < 2; ++sub) {
                    f32x4 ac = (f32x4){0.f, 0.f, 0.f, 0.f};
#pragma unroll
                    for (int kk = 0; kk < 2; ++kk) { const bf16x8 af = *(const LAS bf16x8*)(lds + (32 * blk + 16 * sub + fr) * 160 + (32 * kk + 8 * fq) * 2);
                        ac = __builtin_amdgcn_mfma_f32_16x16x32_bf16(af, qf[kk], ac, 0, 0, 0); }
                    s[blk][sub] = ac;
                    mx = fmaxf(mx, fmaxf(fmaxf(ac[0], ac[1]), fmaxf(ac[2], ac[3])));
                }
            mx = fmaxf(mx, __shfl_xor(mx, 16)); mx = fmaxf(mx, __shfl_xor(mx, 32));
            float sum = 0.f; bf16x8 pb[8];
#pragma unroll
            for (int blk = 0; blk < 8; ++blk) {
                f32x4 p0, p1;
#pragma unroll
                for (int j = 0; j < 4; ++j) { p0[j] = __builtin_amdgcn_exp2f(s[blk][0][j] - mx); p1[j] = __builtin_amdgcn_exp2f(s[blk][1][j] - mx); }
                sum += (p0[0] + p0[1]) + (p0[2] + p0[3]) + (p1[0] + p1[1]) + (p1[2] + p1[3]);
                const u32x4 pw = pg8::pack8(p0, p1); pb[blk] = __builtin_bit_cast(bf16x8, pw);
            }
            sum += __shfl_xor(sum, 16); sum += __shfl_xor(sum, 32);
            const float inv = 1.0f / sum;
#pragma unroll
            for (int dt = 0; dt < 4; ++dt) {
                f32x4 o = (f32x4){0.f, 0.f, 0.f, 0.f};
#pragma unroll
                for (int blk = 0; blk < 8; ++blk) { const bf16x8 vf = *(const LAS bf16x8*)(lds + VOFF + (16 * dt + fr) * 544 + (32 * blk + 8 * fq) * 2);
                    o = __builtin_amdgcn_mfma_f32_16x16x32_bf16(vf, pb[blk], o, 0, 0, 0); }
                const int d0 = 16 * dt + 4 * fq;
                const u32x2 sg = gall[pass][dt];
                u32x2 wv; wv.x = cvt_pk_bf16(o[0] * inv * bf_lo(sg.x), o[1] * inv * bf_hi(sg.x)); wv.y = cvt_pk_bf16(o[2] * inv * bf_lo(sg.y), o[3] * inv * bf_hi(sg.y));
                *(u32x2*)(GBUF + token * DM + 768 + h * HD + d0) = wv;
            }
            }
        }
#endif
    }
    SEAM(5); STAMP(5);

    if (IN(6)) REPS(6) {
        WSP;
        { pg8::Gemm g{GBUF, WOUT, DM, DM, DM}; pg8::OrderPanel S{G, bid, DM / 64, (size_t)256 * DM * 2, (size_t)256 * DM * 2}; pg8::EpiOut E{OBUF, SSQ};
          pg8::gemm_phase<pg8::EpiOut, pg8::OrderPanel>(lds, g, S, E); }
        TIDS;
        asm volatile("s_waitcnt vmcnt(0)" ::: "memory"); __syncthreads();
        constexpr int BMR = 256;
        for (int panel = bid; panel < NTOK / BMR; panel += G)
        {
            const int nw = 8; int row = panel * BMR + 2 * wave; const int rend = panel * BMR + BMR;
            f32x4 gv[4];
#pragma unroll
            for (int i = 0; i < 4; ++i) gv[i] = *(const f32x4*)(a.g_post + 4 * (lane + 64 * i));
            if (row < rend) {
                float sq0 = (lane < 16) ? SSQ[(size_t)row * 16 + lane] : 0.f, sq1 = (lane < 16) ? SSQ[(size_t)(row + 1) * 16 + lane] : 0.f;
                u32x2 o0[4], o1[4]; f32x4 x0[4], x1[4];
#pragma unroll
                for (int i = 0; i < 4; ++i) { const int c = 4 * (lane + 64 * i);
                    o0[i] = *(const u32x2*)(OBUF + (size_t)row * DM + c); o1[i] = *(const u32x2*)(OBUF + (size_t)(row + 1) * DM + c);
                    x0[i] = __builtin_nontemporal_load((const f32x4*)(a.x + (size_t)row * DM + c)); x1[i] = __builtin_nontemporal_load((const f32x4*)(a.x + (size_t)(row + 1) * DM + c)); }
                for (;;) {
                    const int nrow = row + 2 * nw; const bool more = nrow < rend;
                    float nq0 = 0.f, nq1 = 0.f; u32x2 p0[4], p1[4]; f32x4 y0[4], y1[4];
                    if (more) {
                        nq0 = (lane < 16) ? SSQ[(size_t)nrow * 16 + lane] : 0.f; nq1 = (lane < 16) ? SSQ[(size_t)(nrow + 1) * 16 + lane] : 0.f;
#pragma unroll
                        for (int i = 0; i < 4; ++i) { const int c = 4 * (lane + 64 * i);
                            p0[i] = *(const u32x2*)(OBUF + (size_t)nrow * DM + c); p1[i] = *(const u32x2*)(OBUF + (size_t)(nrow + 1) * DM + c);
                            y0[i] = __builtin_nontemporal_load((const f32x4*)(a.x + (size_t)nrow * DM + c)); y1[i] = __builtin_nontemporal_load((const f32x4*)(a.x + (size_t)(nrow + 1) * DM + c)); }
                    }
                    const float rs0 = rsqrtf(wave_sum(sq0) * (1.0f / DM) + EPS), rs1 = rsqrtf(wave_sum(sq1) * (1.0f / DM) + EPS);
#pragma unroll
                    for (int i = 0; i < 4; ++i) { const int c = 4 * (lane + 64 * i);
                        f32x4 r;
                        r[0] = x0[i][0] + bf_lo(o0[i].x) * rs0 * gv[i][0]; r[1] = x0[i][1] + bf_hi(o0[i].x) * rs0 * gv[i][1]; r[2] = x0[i][2] + bf_lo(o0[i].y) * rs0 * gv[i][2]; r[3] = x0[i][3] + bf_hi(o0[i].y) * rs0 * gv[i][3];
                        __builtin_nontemporal_store(r, (f32x4*)(a.out + (size_t)row * DM + c));
                        r[0] = x1[i][0] + bf_lo(o1[i].x) * rs1 * gv[i][0]; r[1] = x1[i][1] + bf_hi(o1[i].x) * rs1 * gv[i][1]; r[2] = x1[i][2] + bf_lo(o1[i].y) * rs1 * gv[i][2]; r[3] = x1[i][3] + bf_hi(o1[i].y) * rs1 * gv[i][3];
                        __builtin_nontemporal_store(r, (f32x4*)(a.out + (size_t)(row + 1) * DM + c)); }
                    if (!more) break;
                    sq0 = nq0; sq1 = nq1;
#pragma unroll
                    for (int i = 0; i < 4; ++i) { o0[i] = p0[i]; o1[i] = p1[i]; x0[i] = y0[i]; x1[i] = y1[i]; }
                    row = nrow;
                }
            }
        }
    }
#ifdef PROBE_TS
    STAMP(6);
    if (blockIdx.x == 0 && threadIdx.x == 0) {
        volatile LAS unsigned long long* tsp = (volatile LAS unsigned long long*)(lds + 131072 + 64);
#ifndef PROBE_TS_TO
#define PROBE_TS_TO (PROBE_TS + 1)
#endif
#ifndef PROBE_MUL
#define PROBE_MUL 1
#endif
        const unsigned long long d = PROBE_MUL * (tsp[PROBE_TS_TO] - tsp[PROBE_TS]), t0 = __builtin_amdgcn_s_memrealtime();
        while (__builtin_amdgcn_s_memrealtime() - t0 < d) __builtin_amdgcn_s_sleep(8);
    }
#endif
#undef IN
#undef SEAM
}

extern "C" void kernel_launch(void* const* d_in, const int* in_sizes, int n_in, void* d_out, int out_size, void* d_ws, size_t ws_size, hipStream_t stream) {
    static int grid = 0;
    if (grid == 0) {
        if (n_in != 19 || ws_size < WS_END) { fprintf(stderr, "kernel_launch: unexpected inputs (n_in %d, ws %zu < %zu)\n", n_in, ws_size, (size_t)WS_END); grid = -1; return; }
        int dev = 0, cus = 0, per_cu = 0;
        hipGetDevice(&dev); hipDeviceGetAttribute(&cus, hipDeviceAttributeMultiprocessorCount, dev);
        if (hipFuncSetAttribute((const void*)mega, hipFuncAttributeMaxDynamicSharedMemorySize, LDS_BYTES) != hipSuccess) { fprintf(stderr, "kernel_launch: hipFuncSetAttribute failed\n"); grid = -1; return; }
        if (hipOccupancyMaxActiveBlocksPerMultiprocessor(&per_cu, (const void*)mega, 512, LDS_BYTES) != hipSuccess || per_cu < 1) { fprintf(stderr, "kernel_launch: occupancy query says %d\n", per_cu); per_cu = 1; }
        (void)hipGetLastError();
        grid = cus;
    }
    if (grid < 0) return;
    Args a{};
    a.x = (const float*)d_in[0]; a.mem = (const float*)d_in[1]; a.g_pre = (const float*)d_in[2]; a.w_in = (const float*)d_in[3]; a.w_pool = (const float*)d_in[4];
    a.pool_scale = (const float*)d_in[5]; a.a_re = (const float*)d_in[6]; a.a_im = (const float*)d_in[7]; a.log_dt = (const float*)d_in[8]; a.b_re = (const float*)d_in[9];
    a.b_im = (const float*)d_in[10]; a.c_re = (const float*)d_in[11]; a.c_im = (const float*)d_in[12]; a.d_skip = (const float*)d_in[13]; a.w_glu = (const float*)d_in[14];
    a.g_mem = (const float*)d_in[15]; a.w_kv = (const float*)d_in[16]; a.w_out = (const float*)d_in[17]; a.g_post = (const float*)d_in[18];
    a.out = (float*)d_out; a.ws = (unsigned char*)d_ws;
    (void)hipMemsetAsync((char*)d_ws + WS_CTL, 0, CTL_BYTES, stream);
#if ONE_LAUNCH
    a.ph_lo = 0; a.ph_hi = 8;
    void* args[] = {&a};
    hipError_t e = hipLaunchCooperativeKernel((const void*)mega, dim3(grid), dim3(512), args, LDS_BYTES, stream);
    if (e != hipSuccess) fprintf(stderr, "kernel_launch: cooperative launch failed: %s (grid %d)\n", hipGetErrorString(e), grid);
#else
    for (int p = 0; p < 8; ++p) { a.ph_lo = p; a.ph_hi = p + 1; hipLaunchKernelGGL(mega, dim3(grid), dim3(512), LDS_BYTES, stream, a); }
#endif
}
```

```cpp
#include <hip/hip_runtime.h>
#include <hip/hip_cooperative_groups.h>
#include <cstdio>
#include <cstdint>
namespace cg = cooperative_groups;

#ifndef ONE_LAUNCH
#define ONE_LAUNCH 1
#endif

#define LAS __attribute__((address_space(3)))
typedef unsigned short bf16_t;
typedef short bf16x8 __attribute__((ext_vector_type(8)));
typedef float f32x4 __attribute__((ext_vector_type(4)));
typedef unsigned u32x4 __attribute__((ext_vector_type(4)));
typedef unsigned u32x2 __attribute__((ext_vector_type(2)));

constexpr int NB = 32, SEQ = 2048, DM = 1024, NTOK = NB * SEQ;
constexpr int POOLW = 384, SSMW = 384, ATTW = 256, INW = 2048;
constexpr int NG = 24, SN = 64, SG = 16;
constexpr int CT = 32, NCH = SEQ / CT, NRC = NB * NCH;
constexpr int UK = CT * SG;
constexpr int UTILE = 256 * 64;
constexpr int NMEM = 256, NH = 4, HD = 64;
constexpr float EPS = 1e-6f;

constexpr size_t MB_ = 1024 * 1024;
constexpr size_t WS_HB = 0;
constexpr size_t WS_PROJ = WS_HB + 128 * MB_;
constexpr size_t WS_UBUF = WS_PROJ + 256 * MB_;
constexpr size_t WS_SEND = WS_UBUF + (size_t)NG * 8 * 10 * UTILE * 2;
constexpr size_t WS_YBUF = WS_SEND + (size_t)NRC * 3072 * 4;
constexpr size_t WS_SSQ = WS_YBUF + (size_t)NTOK * 384 * 2;
constexpr size_t WS_MB = WS_SSQ + (size_t)NTOK * 16 * 4;
constexpr size_t WS_KB = WS_MB + (size_t)8192 * 1024 * 2;
constexpr size_t WS_VT = WS_KB + (size_t)NB * NH * NMEM * HD * 2;
constexpr size_t WS_WIN = WS_VT + (size_t)NB * NH * NMEM * HD * 2;
constexpr size_t WS_WKV = WS_WIN + (size_t)2048 * 1024 * 2;
constexpr size_t WS_WGLU = WS_WKV + (size_t)512 * 1024 * 2;
constexpr size_t WS_WOUT = WS_WGLU + (size_t)768 * 384 * 2;
constexpr size_t WS_BS1 = WS_WOUT + (size_t)1024 * 1024 * 2;
constexpr size_t WS_BS2 = WS_BS1 + (size_t)12 * 256 * 1280 * 2;
constexpr size_t WS_LAMT = WS_BS2 + (size_t)24 * 512 * 640 * 2;
constexpr size_t WS_CTL = WS_LAMT + (size_t)24 * 64 * 2 * 4;
constexpr size_t CTL_BYTES = 16384;
constexpr size_t WS_END = WS_CTL + CTL_BYTES;

#ifndef POOL_A_N
#define POOL_A_N 144
#endif
constexpr int POOL_A = POOL_A_N;
constexpr int LDS_BYTES = 147456;

__device__ __forceinline__ unsigned cvt_pk_bf16(float lo, float hi) { unsigned r; asm volatile("v_cvt_pk_bf16_f32 %0, %1, %2" : "=v"(r) : "v"(lo), "v"(hi)); return r; }
__device__ __forceinline__ bf16_t f2bf(float f) { return (bf16_t)(cvt_pk_bf16(f, 0.f) & 0xffffu); }
__device__ __forceinline__ float bf_lo(unsigned w) { return __uint_as_float(w << 16); }
__device__ __forceinline__ float bf_hi(unsigned w) { return __uint_as_float(w & 0xffff0000u); }
__device__ __forceinline__ float sigmoid_f(float v) { return __builtin_amdgcn_rcpf(1.0f + __builtin_amdgcn_exp2f(-1.44269504f * v)); }
__device__ __forceinline__ float silu_f(float v) { return v * sigmoid_f(v); }
__device__ __forceinline__ float gelu_tanh_f(float v) { const float z = 0.7978845608f * (v + 0.044715f * v * v * v); return v * sigmoid_f(2.0f * z); }

namespace pg8 {
constexpr int BM = 256, BK = 64, HALF = 128, HTB = HALF * BK * 2, STAGE_BYTES = 8 * HTB, NXCD = 8, WGM = 8;
__host__ __device__ __forceinline__ int lds_byte(int r, int c) { const int st = (r >> 4) * 2 + (c >> 5), rr = r & 15, cc = c & 31, ob = rr * 64 + cc * 2; return st * 1024 + (ob ^ (((ob >> 9) & 1) << 5)); }
__host__ __device__ __forceinline__ void stage_rc(int b, int& R, int& C) { const int st = b / 1024, sb = b % 1024, swz = sb ^ (((sb >> 9) & 1) << 5); R = (st >> 1) * 16 + swz / 64; C = (st & 1) * 32 + (swz % 64) / 2; }
__host__ __device__ __forceinline__ int perm32(int rho) { const int n = rho >> 4, i = rho & 15; return 8 * (i >> 2) + 4 * n + (i & 3); }

struct Unit { int pm, pn, aux, nt, skat, skbyA, skbyB; size_t aoff, boff; };
struct Gemm { const bf16_t* A; const bf16_t* Bt; int lda, ldb; size_t kstepA, kstepB; };

struct OrderStd {
    int nM, nN, nwg, G, c, ntiles; size_t astep, bstep;
    __device__ void init(int M, int N, int lda, int ldb, int G_, int c_, int K) { ntiles = K / BK; nM = M / BM; nN = N / BM; nwg = nM * nN; G = G_; c = c_; astep = (size_t)BM * lda * 2; bstep = (size_t)BM * ldb * 2; }
    __device__ bool next(int i, Unit& u) const {
        const long L = (long)i * G + c; if (L >= nwg) return false;
        int wgid = (int)L; { const int q = nwg / NXCD, r = nwg % NXCD, xcd = wgid % NXCD, off = wgid / NXCD; wgid = (xcd < r ? xcd * (q + 1) : r * (q + 1) + (xcd - r) * q) + off; }
        const int nig = WGM * nN, gid = wgid / nig, fm = gid * WGM, gsz = (nM - fm) < WGM ? (nM - fm) : WGM;
        u.pm = fm + ((wgid % nig) % gsz); u.pn = (wgid % nig) / gsz; u.aux = 0; u.nt = ntiles; u.skat = 1 << 30; u.skbyA = 0; u.skbyB = 0; u.aoff = (size_t)u.pm * astep; u.boff = (size_t)u.pn * bstep; return true;
    }
};
struct OrderPanel {
    int G, c, ntiles; size_t astep, bstep;
    __device__ bool next(int i, Unit& u) const {
        const int L = c + (i >> 2) * G; if (L >= NTOK / BM) return false;
        u.pm = L; u.pn = i & 3; u.aux = 0; u.nt = ntiles; u.skat = 1 << 30; u.skbyA = 0; u.skbyB = 0; u.aoff = (size_t)u.pm * astep; u.boff = (size_t)u.pn * bstep; return true;
    }
};
struct OrderS1 {
    int G, c;
    __device__ bool next(int i, Unit& u) const {
        const long L = (long)i * G + c; if (L >= 96) return false;
        u.pm = (int)L / 12; u.pn = (int)L % 12; u.aux = 0; u.nt = 16; u.skat = 8; u.skbyA = 72; u.skbyB = 2;
        u.aoff = ((size_t)(2 * u.pn) * 8 + u.pm) * 10 * UTILE * 2; u.boff = (size_t)u.pn * 256 * 1280 * 2; return true;
    }
};
struct OrderS2 {
    int G, c;
    __device__ bool next(int i, Unit& u) const {
        const long L = (long)i * G + c; if (L >= 384) return false;
        const int g = (int)L / 16, rem = (int)L % 16; u.pm = rem >> 1; u.pn = (rem & 1) ^ (i & 1); u.aux = g; u.nt = u.pn ? 10 : 6; u.skat = u.pn ? (1 << 30) : 4; u.skbyA = u.pn ? 0 : 4; u.skbyB = u.skbyA;
        u.aoff = ((size_t)g * 8 + u.pm) * 10 * UTILE * 2; u.boff = ((size_t)g * 512 + (size_t)u.pn * 256) * 640 * 2; return true;
    }
};

template <class Epi, class Sched>
__device__ __forceinline__ void gemm_phase(LAS unsigned char* lds, const Gemm g, const Sched& S, const Epi& E) {
    const int tid = threadIdx.x, wid = __builtin_amdgcn_readfirstlane(tid >> 6), lane = tid & 63, wr = wid >> 2, wc = wid & 3, fr = lane & 15, fq = lane >> 4;
    unsigned voffA[2], voffB[2];
#pragma unroll
    for (int i = 0; i < 2; ++i) { int R, C; stage_rc(tid * 16 + i * 8192, R, C); const int Rb = Epi::PERM ? ((R & ~31) + perm32(R & 31)) : R;
        voffA[i] = (unsigned)(R * g.lda + C) * 2u; voffB[i] = (unsigned)(Rb * g.ldb + C) * 2u; }
    const size_t kstepA = g.kstepA, kstepB = g.kstepB;
    const size_t hstepA = (size_t)HALF * g.lda * 2, hstepB = (size_t)HALF * g.ldb * 2;
    const unsigned ldsw = (unsigned)wid * 1024u;
    const int aoff = lds_byte(wr * 64 + fr, fq * 8), boff = lds_byte(wc * 32 + fr, fq * 8);
#define PG8_SA(b, h) (((b) * 2 + (h)) * HTB)
#define PG8_SB(b, h) ((4 + (b) * 2 + (h)) * HTB)
#define PG8_STAGE(bufoff, gbase, voff) do { _Pragma("unroll") for (int _i = 0; _i < 2; ++_i) \
        __builtin_amdgcn_global_load_lds((const unsigned*)((const char*)(gbase) + (voff)[_i]), (LAS unsigned*)(lds + (bufoff) + ldsw + _i * 8192), 16, 0, 0); } while (0)
#define PG8_LDA(dst, b, h) do { _Pragma("unroll") for (int m = 0; m < 4; ++m) _Pragma("unroll") for (int k = 0; k < 2; ++k) dst[m][k] = *(const LAS bf16x8*)(lds + PG8_SA(b, h) + aoff + m * 2048 + k * 1024); } while (0)
#define PG8_LDB(dst, b, h) do { _Pragma("unroll") for (int n = 0; n < 2; ++n) _Pragma("unroll") for (int k = 0; k < 2; ++k) dst[n][k] = *(const LAS bf16x8*)(lds + PG8_SB(b, h) + boff + n * 2048 + k * 1024); } while (0)
#define PG8_MMA(ai, bj, At, Bt) do { __builtin_amdgcn_s_setprio(1); _Pragma("unroll") for (int m = 0; m < 4; ++m) _Pragma("unroll") for (int n = 0; n < 2; ++n) _Pragma("unroll") for (int k = 0; k < 2; ++k) \
        acc[ai][bj][m][n] = __builtin_amdgcn_mfma_f32_16x16x32_bf16(Bt[n][k], At[m][k], acc[ai][bj][m][n], 0, 0, 0); __builtin_amdgcn_s_setprio(0); } while (0)
#define PG8_WAIT_V(n) asm volatile("s_waitcnt vmcnt(" #n ")" ::: "memory")
#define PG8_WAIT_L(n) asm volatile("s_waitcnt lgkmcnt(" #n ")" ::: "memory")
#define PG8_BAR __builtin_amdgcn_s_barrier()
#define PG8_SCHED __builtin_amdgcn_sched_barrier(0)
    Unit cur, nxt; int ui = 0;
    if (!S.next(0, cur)) return;
    int nt = cur.nt;
    f32x4 acc[2][2][4][2];
#pragma unroll
    for (int a = 0; a < 2; ++a)
#pragma unroll
        for (int b = 0; b < 2; ++b)
#pragma unroll
            for (int m = 0; m < 4; ++m)
#pragma unroll
                for (int n = 0; n < 2; ++n) acc[a][b][m][n] = (f32x4){0.f, 0.f, 0.f, 0.f};
    bf16x8 At[4][2], B0[2][2], B1[2][2];
    const char* cA = (const char*)g.A + cur.aoff; const char* cB = (const char*)g.Bt + cur.boff;
    PG8_STAGE(PG8_SB(0, 0), cB, voffB); PG8_STAGE(PG8_SB(0, 1), cB + hstepB, voffB); PG8_STAGE(PG8_SA(0, 0), cA, voffA); PG8_STAGE(PG8_SA(0, 1), cA + hstepA, voffA);
    if (wr == 1) PG8_BAR;
    PG8_WAIT_V(2); PG8_BAR;
    PG8_STAGE(PG8_SB(1, 0), cB + kstepB, voffB); PG8_STAGE(PG8_SA(1, 0), cA + kstepA, voffA); PG8_STAGE(PG8_SB(1, 1), cB + hstepB + kstepB, voffB);
    PG8_WAIT_V(6); PG8_BAR;
    for (;;) {
        const bool has_next = S.next(ui + 1, nxt);
        const char* nA = has_next ? (const char*)g.A + nxt.aoff : cA; const char* nB = has_next ? (const char*)g.Bt + nxt.boff : cB;
#pragma unroll 1
        for (int t = 0; t < nt; t += 2) {
            const bool last = (t == nt - 2);
            const size_t oa1 = (size_t)(t + 1 + (t + 1 >= cur.skat ? cur.skbyA : 0)) * kstepA, oa2 = (size_t)(t + 2 + (t + 2 >= cur.skat ? cur.skbyA : 0)) * kstepA;
            const size_t ob2 = (size_t)(t + 2 + (t + 2 >= cur.skat ? cur.skbyB : 0)) * kstepB;
            const char* a1 = cA + oa1;
            const char* a2 = last ? nA : cA + oa2; const char* b2 = last ? nB : cB + ob2;
            const char* a3 = a2 + kstepA; const char* b3 = b2 + kstepB;
            PG8_LDB(B0, 0, 0); PG8_LDB(B1, 0, 1); PG8_SCHED; PG8_LDA(At, 0, 0); PG8_STAGE(PG8_SA(1, 1), a1 + hstepA, voffA);
            PG8_WAIT_V(8); PG8_WAIT_L(0); PG8_BAR; PG8_MMA(0, 0, At, B0); PG8_MMA(0, 1, At, B1); PG8_BAR; PG8_SCHED;
            PG8_LDA(At, 0, 1); PG8_STAGE(PG8_SB(0, 0), b2, voffB); PG8_STAGE(PG8_SB(0, 1), b2 + hstepB, voffB); PG8_STAGE(PG8_SA(0, 0), a2, voffA);
            PG8_WAIT_V(8); PG8_WAIT_L(0); PG8_BAR; PG8_MMA(1, 0, At, B0); PG8_MMA(1, 1, At, B1); PG8_BAR; PG8_SCHED;
            PG8_LDB(B0, 1, 0); PG8_LDB(B1, 1, 1); PG8_SCHED; PG8_LDA(At, 1, 0); PG8_STAGE(PG8_SA(0, 1), a2 + hstepA, voffA);
            PG8_WAIT_V(8); PG8_WAIT_L(0); PG8_BAR; PG8_MMA(0, 0, At, B0); PG8_MMA(0, 1, At, B1); PG8_BAR; PG8_SCHED;
            PG8_LDA(At, 1, 1); PG8_STAGE(PG8_SB(1, 0), b3, voffB); PG8_STAGE(PG8_SB(1, 1), b3 + hstepB, voffB); PG8_STAGE(PG8_SA(1, 0), a3, voffA);
            PG8_WAIT_V(8); PG8_WAIT_L(0); PG8_BAR; PG8_MMA(1, 0, At, B0); PG8_MMA(1, 1, At, B1); PG8_BAR; PG8_SCHED;
        }
        if (wr == 0) PG8_BAR;
        E(acc, cur, wr, wc, fr, fq);
        if (!has_next) break;
#pragma unroll
        for (int a = 0; a < 2; ++a)
#pragma unroll
            for (int b = 0; b < 2; ++b)
#pragma unroll
                for (int m = 0; m < 4; ++m)
#pragma unroll
                    for (int n = 0; n < 2; ++n) acc[a][b][m][n] = (f32x4){0.f, 0.f, 0.f, 0.f};
        cur = nxt; cA = nA; cB = nB; ++ui; nt = cur.nt;
        if (wr == 1) PG8_BAR;
    }
    PG8_WAIT_V(0);
    PG8_BAR;
#undef PG8_SA
#undef PG8_SB
#undef PG8_STAGE
#undef PG8_LDA
#undef PG8_LDB
#undef PG8_MMA
#undef PG8_WAIT_V
#undef PG8_WAIT_L
#undef PG8_BAR
#undef PG8_SCHED
}

typedef f32x4 Acc[2][2][4][2];
__device__ __forceinline__ u32x4 pack8(f32x4 v0, f32x4 v1) { u32x4 w; w.x = cvt_pk_bf16(v0[0], v0[1]); w.y = cvt_pk_bf16(v0[2], v0[3]); w.z = cvt_pk_bf16(v1[0], v1[1]); w.w = cvt_pk_bf16(v1[2], v1[3]); return w; }

struct EpiIn {
    static constexpr bool PERM = true;
    bf16_t* PROJ; bf16_t* UBUF;
    __device__ __forceinline__ void operator()(const Acc& acc, const Unit& u, int wr, int wc, int fr, int fq) const {
#pragma unroll
        for (int bj = 0; bj < 2; ++bj) {
            const int blk = 2 * u.pn + bj, col0 = 128 * blk + 32 * wc + 8 * fq;
#pragma unroll
            for (int ai = 0; ai < 2; ++ai)
#pragma unroll
                for (int m = 0; m < 4; ++m) {
                    const int row = u.pm * BM + ai * HALF + wr * 64 + m * 16 + fr;
                    f32x4 v0 = acc[ai][bj][m][0], v1 = acc[ai][bj][m][1];
                    if (blk >= 8) {
#pragma unroll
                        for (int j = 0; j < 4; ++j) { v0[j] = silu_f(v0[j]); v1[j] = silu_f(v1[j]); }
                    } else if (blk >= 6) { v0 = v0 * 0.18033688f; v1 = v1 * 0.18033688f; }
                    const u32x4 w = pack8(v0, v1);
                    if (blk >= 3 && blk < 6) { const int cc = col0 - 384, gg = cc >> 4, cin = cc & 15;
                        const int rc = row >> 5, kk = (row & 31) * 16 + cin;
                        *(u32x4*)(UBUF + ((size_t)((gg * 8 + (rc >> 8)) * 10 + (kk >> 6)) * 256 + (rc & 255)) * 64 + (kk & 63)) = w; }
                    else *(u32x4*)(PROJ + (size_t)row * INW + col0) = w;
                }
        }
    }
};
struct EpiS1 {
    static constexpr bool PERM = false;
    float* SEND;
    __device__ __forceinline__ void operator()(const Acc& acc, const Unit& u, int wr, int wc, int fr, int fq) const {
        const int row0 = u.pm * BM + wr * 64 + fr, col0 = u.pn * BM + wc * 32 + 4 * fq;
#pragma unroll
        for (int ai = 0; ai < 2; ++ai)
#pragma unroll
            for (int m = 0; m < 4; ++m) { float* rowp = SEND + (size_t)(row0 + ai * HALF + m * 16) * 3072 + col0;
#pragma unroll
                for (int bj = 0; bj < 2; ++bj)
#pragma unroll
                    for (int n = 0; n < 2; ++n) *(f32x4*)(rowp + bj * HALF + n * 16) = acc[ai][bj][m][n]; }
    }
};
struct EpiKV {
    static constexpr bool PERM = true;
    bf16_t* KB; bf16_t* VT;
    __device__ __forceinline__ void operator()(const Acc& acc, const Unit& u, int wr, int wc, int fr, int fq) const {
#pragma unroll
        for (int bj = 0; bj < 2; ++bj) {
            const int c0 = 128 * bj + 32 * wc + 8 * fq, hh = c0 >> 6, d0 = c0 & 63;
#pragma unroll
            for (int ai = 0; ai < 2; ++ai)
#pragma unroll
                for (int m = 0; m < 4; ++m) {
                    const int row = u.pm * BM + ai * HALF + wr * 64 + m * 16 + fr, b = row >> 8, mm = row & 255;
                    const f32x4 v0 = acc[ai][bj][m][0], v1 = acc[ai][bj][m][1];
                    bf16_t* dstb = (u.pn == 0) ? KB : VT;
                    *(u32x4*)(dstb + ((size_t)(b * NH + hh) * NMEM + mm) * HD + d0) = pack8(v0, v1);
                }
        }
    }
};
struct EpiS2 {
    static constexpr bool PERM = true;
    bf16_t* YB;
    __device__ __forceinline__ void operator()(const Acc& acc, const Unit& u, int wr, int wc, int fr, int fq) const {
#pragma unroll
        for (int bj = 0; bj < 2; ++bj) {
            const int j0 = u.pn * BM + 128 * bj + 32 * wc + 8 * fq, t = j0 >> 4, cp = j0 & 15;
#pragma unroll
            for (int ai = 0; ai < 2; ++ai)
#pragma unroll
                for (int m = 0; m < 4; ++m) {
                    const int row = u.pm * BM + ai * HALF + wr * 64 + m * 16 + fr;
                    f32x4 v0 = acc[ai][bj][m][0], v1 = acc[ai][bj][m][1];
#pragma unroll
                    for (int j = 0; j < 4; ++j) { v0[j] = gelu_tanh_f(v0[j]); v1[j] = gelu_tanh_f(v1[j]); }
                    *(u32x4*)(YB + ((size_t)row * CT + t) * SSMW + u.aux * SG + cp) = pack8(v0, v1);
                }
        }
    }
};
struct EpiGlu {
    static constexpr bool PERM = true;
    const bf16_t* PROJ; bf16_t* GB;
    __device__ __forceinline__ void operator()(const Acc& acc, const Unit& u, int wr, int wc, int fr, int fq) const {
        const int jj0 = (u.pn * BM + 32 * wc + 8 * fq) >> 1;
        const unsigned row0 = (unsigned)(u.pm * BM + wr * 64 + fr);
        const unsigned goff0 = (row0 * INW + 1024 + 384 + jj0) * 2u, ooff0 = (row0 * DM + 384 + jj0) * 2u;
        u32x2 sgv[2][4][2];
#pragma unroll
        for (int ai = 0; ai < 2; ++ai)
#pragma unroll
            for (int m = 0; m < 4; ++m)
#pragma unroll
                for (int bj = 0; bj < 2; ++bj) sgv[ai][m][bj] = *(const u32x2*)((const char*)PROJ + (goff0 + (unsigned)(ai * HALF + m * 16) * INW * 2u + 128u * bj));
        asm volatile("" ::: "memory");
#pragma unroll
        for (int ai = 0; ai < 2; ++ai)
#pragma unroll
            for (int m = 0; m < 4; ++m) {
                const unsigned ooff = ooff0 + (unsigned)(ai * HALF + m * 16) * DM * 2u;
#pragma unroll
                for (int bj = 0; bj < 2; ++bj) {
                    const f32x4 z1 = acc[ai][bj][m][0], z2 = acc[ai][bj][m][1];
                    const u32x2 sg = sgv[ai][m][bj];
                    const float o0 = z1[0] * sigmoid_f(z2[0]) * bf_lo(sg.x), o1 = z1[1] * sigmoid_f(z2[1]) * bf_hi(sg.x);
                    const float o2 = z1[2] * sigmoid_f(z2[2]) * bf_lo(sg.y), o3 = z1[3] * sigmoid_f(z2[3]) * bf_hi(sg.y);
                    u32x2 w; w.x = cvt_pk_bf16(o0, o1); w.y = cvt_pk_bf16(o2, o3);
                    *(u32x2*)((char*)GB + (ooff + 128u * bj)) = w;
                }
            }
    }
};
struct EpiOut {
    static constexpr bool PERM = true;
    bf16_t* OB; float* SSQ;
    __device__ __forceinline__ void operator()(const Acc& acc, const Unit& u, int wr, int wc, int fr, int fq) const {
#pragma unroll
        for (int ai = 0; ai < 2; ++ai)
#pragma unroll
            for (int m = 0; m < 4; ++m) {
                const int row = u.pm * BM + ai * HALF + wr * 64 + m * 16 + fr;
                float s = 0.f;
#pragma unroll
                for (int bj = 0; bj < 2; ++bj) {
                    const int col0 = u.pn * BM + 128 * bj + 32 * wc + 8 * fq;
                    const f32x4 v0 = acc[ai][bj][m][0], v1 = acc[ai][bj][m][1];
                    s += (v0[0] * v0[0] + v0[1] * v0[1]) + (v0[2] * v0[2] + v0[3] * v0[3]) + (v1[0] * v1[0] + v1[1] * v1[1]) + (v1[2] * v1[2] + v1[3] * v1[3]);
                    *(u32x4*)(OB + (size_t)row * DM + col0) = pack8(v0, v1);
                }
                s += __shfl_xor(s, 16); s += __shfl_xor(s, 32);
                if (fq == 0) SSQ[(size_t)row * 16 + u.pn * 4 + wc] = s;
            }
    }
};
}


#define XB_TMO      128
#define XB_XCNT(j)  (256  + 64 * (j))
#define XB_XSUB(j)  (1280 + 64 * (j))
#define XB_XGEN(j)  (2304 + 64 * (j))
#define XB_TOP      3328
#define XB_TOPGEN   3392
#define XCD_BAR_WORDS 3456
#define XB_SPIN_CAP (1u << 18)
__device__ __forceinline__ unsigned xb_ld(unsigned* p)              { return __hip_atomic_load(p, __ATOMIC_RELAXED, __HIP_MEMORY_SCOPE_AGENT); }
__device__ __forceinline__ unsigned xb_add(unsigned* p, unsigned v) { return __hip_atomic_fetch_add(p, v, __ATOMIC_RELAXED, __HIP_MEMORY_SCOPE_AGENT); }
__device__ __forceinline__ unsigned xb_xcc_id() { return (unsigned)__builtin_amdgcn_s_getreg((3 << 11) | 20) & 0xFu; }
#define XB_SPIN(cond, bar) do { unsigned _sp = 0; while (cond) { __builtin_amdgcn_s_sleep(1); \
    if ((++_sp & 255u) == 0u) { if (xb_ld(&(bar)[XB_TMO])) break; if (_sp > XB_SPIN_CAP) { atomicAdd(&(bar)[XB_TMO], 1u); break; } } } } while (0)
struct XcdBarrier { unsigned* bar; unsigned x; volatile LAS unsigned* st; };
__device__ __forceinline__ XcdBarrier xcd_barrier_post(unsigned* bar, volatile LAS unsigned* st) {
    XcdBarrier b; b.bar = bar; b.x = xb_xcc_id(); b.st = st;
    if (threadIdx.x == 0) (void)xb_add(&bar[XB_XCNT(b.x)], 1u);
    return b;
}
__device__ __forceinline__ void xcd_barrier_complete(unsigned* bar, unsigned x, unsigned& nloc, unsigned& nx) {
    const unsigned G = gridDim.x * gridDim.y * gridDim.z;
    unsigned sum, cnt, mine, sp = 0u;
    for (;;) {
        sum = 0u; cnt = 0u; mine = 0u;
#pragma unroll
        for (unsigned j = 0; j < 16; ++j) { const unsigned c = xb_ld(&bar[XB_XCNT(j)]); sum += c; cnt += (c > 0u) ? 1u : 0u; mine = (j == x) ? c : mine; }
        if (sum == G) break;
        __builtin_amdgcn_s_sleep(1);
        if ((++sp & 255u) == 0u) { if (xb_ld(&bar[XB_TMO])) break; if (sp > XB_SPIN_CAP) { atomicAdd(&bar[XB_TMO], 1u); break; } }
    }
    nloc = mine > 0u ? mine : 1u; nx = cnt > 0u ? cnt : 1u;
}
__device__ __forceinline__ void xcd_barrier(const XcdBarrier& b) {
    asm volatile("s_waitcnt vmcnt(0)" ::: "memory");
    __syncthreads();
    if (threadIdx.x == 0) {
        unsigned* bar = b.bar;
        __builtin_amdgcn_s_waitcnt(0);
        unsigned nloc = b.st[0], nx = b.st[1];
        if (nloc == 0u) { xcd_barrier_complete(bar, b.x, nloc, nx); b.st[0] = nloc; b.st[1] = nx; }
        const unsigned old = xb_add(&bar[XB_XSUB(b.x)], 1u);
        const unsigned gen = old / nloc;
        if (old + 1u == (gen + 1u) * nloc) {
            __builtin_amdgcn_fence(__ATOMIC_RELEASE, "agent");
            asm volatile("s_waitcnt vmcnt(0)" ::: "memory");
            const unsigned og = xb_add(&bar[XB_TOP], 1u);
            const unsigned tg = og / nx;
            if (og + 1u == (tg + 1u) * nx) xb_add(&bar[XB_TOPGEN], 1u);
            else XB_SPIN(xb_ld(&bar[XB_TOPGEN]) == tg, bar);
            __builtin_amdgcn_fence(__ATOMIC_ACQUIRE, "agent");
            xb_add(&bar[XB_XGEN(b.x)], 1u);
            asm volatile("s_waitcnt vmcnt(0)" ::: "memory");
        } else {
            XB_SPIN(xb_ld(&bar[XB_XGEN(b.x)]) == gen, bar);
            __builtin_amdgcn_fence(__ATOMIC_ACQUIRE, "agent");
            asm volatile("s_waitcnt vmcnt(0)" ::: "memory");
        }
    }
    __syncthreads();
}

struct Args {
    const float* x; const float* mem; const float* g_pre; const float* w_in; const float* w_pool; const float* pool_scale;
    const float* a_re; const float* a_im; const float* log_dt; const float* b_re; const float* b_im; const float* c_re; const float* c_im;
    const float* d_skip; const float* w_glu; const float* g_mem; const float* w_kv; const float* w_out; const float* g_post;
    float* out; unsigned char* ws; int ph_lo, ph_hi;
};

__device__ __forceinline__ float wave_sum(float v) {
    v += __shfl_xor(v, 32); v += __shfl_xor(v, 16); v += __shfl_xor(v, 8); v += __shfl_xor(v, 4); v += __shfl_xor(v, 2); v += __shfl_xor(v, 1); return v;
}

__device__ __forceinline__ void rmsnorm_rows(const float* src, const float* g, bf16_t* dst, int nrows, int gwave, int nwaves, int lane) {
    int row = 2 * gwave;
    if (row >= nrows) return;
    f32x4 v0[4], v1[4];
    { const f32x4* p0 = (const f32x4*)(src + (size_t)row * DM); const f32x4* p1 = p0 + DM / 4;
#pragma unroll
      for (int i = 0; i < 4; ++i) { v0[i] = __builtin_nontemporal_load(p0 + lane + 64 * i); v1[i] = __builtin_nontemporal_load(p1 + lane + 64 * i); } }
    f32x4 gv[4];
#pragma unroll
    for (int i = 0; i < 4; ++i) gv[i] = ((const f32x4*)g)[lane + 64 * i];
    for (;;) {
        const int nrow = row + 2 * nwaves; const bool more = nrow < nrows;
        f32x4 n0[4], n1[4];
        if (more) { const f32x4* p0 = (const f32x4*)(src + (size_t)nrow * DM); const f32x4* p1 = p0 + DM / 4;
#pragma unroll
            for (int i = 0; i < 4; ++i) { n0[i] = __builtin_nontemporal_load(p0 + lane + 64 * i); n1[i] = __builtin_nontemporal_load(p1 + lane + 64 * i); } }
        float ss0 = 0.f, ss1 = 0.f;
#pragma unroll
        for (int i = 0; i < 4; ++i) { ss0 += (v0[i][0] * v0[i][0] + v0[i][1] * v0[i][1]) + (v0[i][2] * v0[i][2] + v0[i][3] * v0[i][3]);
                                      ss1 += (v1[i][0] * v1[i][0] + v1[i][1] * v1[i][1]) + (v1[i][2] * v1[i][2] + v1[i][3] * v1[i][3]); }
        ss0 = wave_sum(ss0); ss1 = wave_sum(ss1);
        const float rs0 = rsqrtf(ss0 * (1.0f / DM) + EPS), rs1 = rsqrtf(ss1 * (1.0f / DM) + EPS);
#pragma unroll
        for (int i = 0; i < 4; ++i) {
            u32x2 w; w.x = cvt_pk_bf16(v0[i][0] * rs0 * gv[i][0], v0[i][1] * rs0 * gv[i][1]); w.y = cvt_pk_bf16(v0[i][2] * rs0 * gv[i][2], v0[i][3] * rs0 * gv[i][3]);
            *(u32x2*)(dst + (size_t)row * DM + 4 * (lane + 64 * i)) = w;
            w.x = cvt_pk_bf16(v1[i][0] * rs1 * gv[i][0], v1[i][1] * rs1 * gv[i][1]); w.y = cvt_pk_bf16(v1[i][2] * rs1 * gv[i][2], v1[i][3] * rs1 * gv[i][3]);
            *(u32x2*)(dst + (size_t)(row + 1) * DM + 4 * (lane + 64 * i)) = w; }
        if (!more) break;
#pragma unroll
        for (int i = 0; i < 4; ++i) { v0[i] = n0[i]; v1[i] = n1[i]; }
        row = nrow;
    }
}

template <int MODE>
__device__ __forceinline__ void tr_tile(const float* src, int ld_src, int k0, int n0, bf16_t* dst, int ld_dst, LAS float* tile, int tid) {
    __syncthreads();
    for (int e = tid; e < 4096; e += 512) { const int kk = e >> 6, nn = e & 63; tile[kk * 65 + nn] = src[(size_t)(k0 + kk) * ld_src + n0 + nn]; }
    __syncthreads();
    for (int e = tid; e < 4096; e += 512) { const int nn = e >> 6, kk = e & 63; int n = n0 + nn;
        if (MODE == 1) { n = (n < 384) ? (8 * (n >> 2) + (n & 3)) : (8 * ((n - 384) >> 2) + 4 + ((n - 384) & 3)); }
        dst[(size_t)n * ld_dst + k0 + kk] = f2bf(tile[kk * 65 + nn]); }
}

template <int W>
__device__ __forceinline__ void pool_seg(const bf16_t* PROJ, bf16_t* GBUF, int b, int t0, int cgp) {
    const bf16_t* zb = PROJ + ((size_t)b * SEQ + t0) * INW + 8 * cgp;
    bf16_t* ob = GBUF + ((size_t)b * SEQ + t0) * DM + 8 * cgp;
    u32x4 hist[W - 1], zc[8], gc[8], nz[8], ng[8];
#pragma unroll
    for (int i = 0; i < W - 1; ++i) hist[i] = (t0 > 0) ? *(const u32x4*)(zb - (size_t)(i + 1) * INW) : (u32x4){0u, 0u, 0u, 0u};
#pragma unroll
    for (int d = 0; d < 8; ++d) { zc[d] = *(const u32x4*)(zb + (size_t)d * INW); gc[d] = *(const u32x4*)(zb + (size_t)d * INW + 1024); }
    float S[8];
#pragma unroll
    for (int q = 0; q < 8; ++q) S[q] = 0.f;
#pragma unroll
    for (int i = 0; i < W - 1; ++i) { const u32x4 v = hist[i];
        S[0] += bf_lo(v.x); S[1] += bf_hi(v.x); S[2] += bf_lo(v.y); S[3] += bf_hi(v.y); S[4] += bf_lo(v.z); S[5] += bf_hi(v.z); S[6] += bf_lo(v.w); S[7] += bf_hi(v.w); }
#pragma unroll 1
    for (int sr = 0; sr < 4; ++sr) {
        if (sr < 3) {
#pragma unroll
            for (int d = 0; d < 8; ++d) { nz[d] = *(const u32x4*)(zb + (size_t)(8 * (sr + 1) + d) * INW); ng[d] = *(const u32x4*)(zb + (size_t)(8 * (sr + 1) + d) * INW + 1024); }
        }
#pragma unroll
        for (int d = 0; d < 8; ++d) {
            const u32x4 v = zc[d], gv = gc[d];
            const float z[8] = {bf_lo(v.x), bf_hi(v.x), bf_lo(v.y), bf_hi(v.y), bf_lo(v.z), bf_hi(v.z), bf_lo(v.w), bf_hi(v.w)};
            const float sg[8] = {bf_lo(gv.x), bf_hi(gv.x), bf_lo(gv.y), bf_hi(gv.y), bf_lo(gv.z), bf_hi(gv.z), bf_lo(gv.w), bf_hi(gv.w)};
            const int tt = t0 + 8 * sr + d + 1; const float inv = 1.0f / (float)(tt < W ? tt : W);
            float o[8];
#pragma unroll
            for (int q = 0; q < 8; ++q) { S[q] += z[q]; o[q] = (S[q] * inv - z[q]) * sg[q]; }
            u32x4 wv; wv.x = cvt_pk_bf16(o[0], o[1]); wv.y = cvt_pk_bf16(o[2], o[3]); wv.z = cvt_pk_bf16(o[4], o[5]); wv.w = cvt_pk_bf16(o[6], o[7]);
            *(u32x4*)(ob + (size_t)(8 * sr + d) * DM) = wv;
            const u32x4 r = (d - W + 1 >= 0) ? zc[(d - W + 1 >= 0) ? (d - W + 1) : 0] : hist[(W - 2 - d >= 0) ? (W - 2 - d) : 0];
            S[0] -= bf_lo(r.x); S[1] -= bf_hi(r.x); S[2] -= bf_lo(r.y); S[3] -= bf_hi(r.y); S[4] -= bf_lo(r.z); S[5] -= bf_hi(r.z); S[6] -= bf_lo(r.w); S[7] -= bf_hi(r.w);
        }
        u32x4 nh[W - 1];
#pragma unroll
        for (int i = 0; i < W - 1; ++i) nh[i] = (i < 8) ? zc[(i < 8) ? (7 - i) : 0] : hist[(i >= 8) ? (i - 8) : 0];
#pragma unroll
        for (int i = 0; i < W - 1; ++i) hist[i] = nh[i];
#pragma unroll
        for (int d = 0; d < 8; ++d) { zc[d] = nz[d]; gc[d] = ng[d]; }
    }
}
__device__ __forceinline__ void pool_item(unsigned char* ws, int id, int tid) {
    const bf16_t* PROJ = (const bf16_t*)(ws + WS_PROJ); bf16_t* GBUF = (bf16_t*)(ws + WS_HB);
    const int b = id >> 3, gi = (id >> 1) & 3, seg = tid / 12, cgp = gi * 12 + (tid - seg * 12), t0 = (id & 1) * 1024 + seg * 32;
    if (seg < 32) {
        if (gi == 0) pool_seg<2>(PROJ, GBUF, b, t0, cgp);
        else if (gi == 1) pool_seg<4>(PROJ, GBUF, b, t0, cgp);
        else if (gi == 2) pool_seg<8>(PROJ, GBUF, b, t0, cgp);
        else pool_seg<16>(PROJ, GBUF, b, t0, cgp);
    }
}
#define QW(k) ((unsigned*)(a.ws + WS_CTL) + 3520 + 64 * (k))

__global__ void __launch_bounds__(512, 2) mega(Args a) {
    extern __shared__ __attribute__((aligned(16))) unsigned char lds_raw[];
    LAS unsigned char* lds = (LAS unsigned char*)lds_raw;
    const int G = gridDim.x, bid = blockIdx.x;
#define TIDS int tid = threadIdx.x; asm volatile("" : "+v"(tid)); const int lane = tid & 63, wave = tid >> 6; (void)lane; (void)wave
#define WSP unsigned char* ws = a.ws; asm volatile("" : "+s"(ws))
#define HB ((bf16_t*)(ws + WS_HB))
#define GBUF ((bf16_t*)(ws + WS_HB))
#define PROJ ((bf16_t*)(ws + WS_PROJ))
#define OBUF ((bf16_t*)(ws + WS_PROJ))
#define UBUF ((bf16_t*)(ws + WS_UBUF))
#define SEND ((float*)(ws + WS_SEND))
#define YBUF ((bf16_t*)(ws + WS_YBUF))
#define SSQ ((float*)(ws + WS_SSQ))
#define MBF ((bf16_t*)(ws + WS_MB))
#define KB ((bf16_t*)(ws + WS_KB))
#define VT ((bf16_t*)(ws + WS_VT))
#define WIN ((bf16_t*)(ws + WS_WIN))
#define WKV ((bf16_t*)(ws + WS_WKV))
#define WGLU ((bf16_t*)(ws + WS_WGLU))
#define WOUT ((bf16_t*)(ws + WS_WOUT))
#define BS1 ((bf16_t*)(ws + WS_BS1))
#define BS2 ((bf16_t*)(ws + WS_BS2))
#define LAMT ((float*)(ws + WS_LAMT))
    const int lo = a.ph_lo, hi = a.ph_hi;
    if (threadIdx.x < 4) ((LAS unsigned*)(lds + 131072))[threadIdx.x] = 0u;
    __syncthreads();
    XcdBarrier gbar; gbar.bar = (unsigned*)(a.ws + WS_CTL); gbar.x = 0; gbar.st = (volatile LAS unsigned*)(lds + 131072);
    if (hi - lo > 1) gbar = xcd_barrier_post((unsigned*)(a.ws + WS_CTL), (volatile LAS unsigned*)(lds + 131072));
    if (hi > 8) cg::this_grid().sync();
#ifdef PROBE_TS
#define STAMP(j) do { if (blockIdx.x == 0 && threadIdx.x == 0) ((volatile LAS unsigned long long*)(lds + 131072 + 64))[j] = __builtin_amdgcn_s_memrealtime(); } while (0)
#else
#define STAMP(j) do {} while (0)
#endif
    STAMP(0);
#ifndef PH_MASK
#define PH_MASK 0xff
#endif
#ifndef PROBE_MASK
#define PROBE_MASK 0
#endif
#define IN(k) (((PH_MASK >> (k)) & 1) && lo <= (k) && (k) < hi)
#define REPS(k) for (int rep_ = 0; rep_ < (((PROBE_MASK >> (k)) & 1) ? 2 : 1); ++rep_)
#define SEAM(k) do { if (IN(k) && IN((k) + 1)) { xcd_barrier(gbar); } } while (0)

    if (IN(0)) REPS(0) {
        WSP;
        TIDS;
        LAS float* sm = (LAS float*)lds;
        constexpr int N_SSM = NG * CT, N_TRIN = 26 * 16, N_TROUT = 256, N_TRGLU = 72, N_TRKV = 128, N_FOLD = 64;
        constexpr int I1 = N_SSM, I2 = I1 + N_TRIN, I3 = I2 + N_TROUT, I4 = I3 + N_TRGLU, I5 = I4 + N_TRKV, I6 = I5 + N_FOLD;
        for (int item = bid; item < I6; item += G) {
            if (item < I1) {
                const int g = item / CT, j = item % CT;
                LAS float* sBr = sm + 512; LAS float* sBi = sm + 1536; LAS float* sCr = sm + 2560; LAS float* sCi = sm + 3616;
                __syncthreads();
#pragma unroll
                for (int r = 0; r < 2; ++r) { const int idx = tid + 512 * r;
                    sBr[idx] = a.b_re[(size_t)g * 1024 + idx]; sBi[idx] = a.b_im[(size_t)g * 1024 + idx];
                    sCr[(idx >> 6) * 65 + (idx & 63)] = a.c_re[(size_t)g * 1024 + idx]; sCi[(idx >> 6) * 65 + (idx & 63)] = a.c_im[(size_t)g * 1024 + idx]; }
                if (tid < 64) {
                    const int n = tid; const float ar = a.a_re[g * SN + n], ai = a.a_im[g * SN + n], dt = expf(a.log_dt[g]);
                    const float xr = ar * dt, yi = ai * dt;
                    float s0, c0, s1, c1, sy, cy;
                    const float m0 = expf((float)j * xr); sincosf((float)j * yi, &s0, &c0);
                    const float m1 = expf((float)(j + 1) * xr); sincosf((float)(j + 1) * yi, &s1, &c1);
                    const float e1 = expm1f(xr); sincosf(yi, &sy, &cy); const float sh = sinf(0.5f * yi);
                    const float br = e1 * cy - 2.f * sh * sh, bi = (e1 + 1.f) * sy;
                    const float den = 1.f / (ar * ar + ai * ai);
                    const float cr = (br * ar + bi * ai) * den, ci = (bi * ar - br * ai) * den;
                    const float ljr = m0 * c0, lji = m0 * s0;
                    sm[n] = ljr; sm[64 + n] = lji; sm[128 + n] = m1 * c1; sm[192 + n] = m1 * s1;
                    sm[256 + n] = ljr * cr - lji * ci; sm[320 + n] = ljr * ci + lji * cr;
                    if (j == CT - 1) { LAMT[(g * SN + n) * 2] = m1 * c1; LAMT[(g * SN + n) * 2 + 1] = m1 * s1; }
                }
                __syncthreads();
                bf16_t* bs2 = BS2 + (size_t)g * 512 * 640;
                if (tid < 256) {
                    const int cp = tid >> 4, c = tid & 15; float kv = 0.f;
                    for (int n = 0; n < SN; ++n) {
                        const float Br = sBr[n * SG + c], Bi = sBi[n * SG + c];
                        const float Cr = sCr[cp * 65 + n], Ci = sCi[cp * 65 + n];
                        const float lr = sm[256 + n], li = sm[320 + n];
                        const float pr = lr * Br - li * Bi, pi = lr * Bi + li * Br;
                        kv += Cr * pr - Ci * pi;
                    }
                    if (j == 0 && c == cp) kv += a.d_skip[g * SG + cp];
                    const bf16_t kb = f2bf(kv);
                    for (int t = j; t < CT; ++t) { const int s = t - j;
                        bs2[(size_t)(t * SG + cp) * 640 + s * SG + c] = kb;
                        if (j > 0) bs2[(size_t)(s * SG + cp) * 640 + t * SG + c] = 0; }
                } else {
#pragma unroll
                    for (int r = 0; r < 4; ++r) { const int idx = (tid - 256) + 256 * r, cp = idx >> 6, n = idx & 63;
                        const float Cr = sCr[cp * 65 + n], Ci = sCi[cp * 65 + n];
                        const float lr = sm[128 + n], li = sm[192 + n];
                        bs2[(size_t)(j * SG + cp) * 640 + 512 + n] = f2bf(Cr * lr - Ci * li);
                        bs2[(size_t)(j * SG + cp) * 640 + 576 + n] = f2bf(-(Cr * li + Ci * lr)); }
                }
                {
                    const int s = CT - 1 - j, p = g >> 1, gl = g & 1;
                    bf16_t* bs1 = BS1 + (size_t)p * 256 * 1280;
#pragma unroll
                    for (int r = 0; r < 2; ++r) { const int idx = tid + 512 * r, n = idx >> 4, c = idx & 15;
                        const float Br = sBr[n * SG + c], Bi = sBi[n * SG + c];
                        const float lr = sm[256 + n], li = sm[320 + n];
                        bs1[(size_t)(gl * 128 + n) * 1280 + gl * 640 + s * SG + c] = f2bf(lr * Br - li * Bi);
                        bs1[(size_t)(gl * 128 + 64 + n) * 1280 + gl * 640 + s * SG + c] = f2bf(lr * Bi + li * Br); }
                    for (int idx = tid; idx < 128 * 24; idx += 512) { const int rr = idx / 24, q = idx % 24; int col;
                        if (q < 16) col = (1 - gl) * 640 + s * SG + q; else if (q < 20) col = gl * 640 + 512 + 4 * s + (q - 16); else col = (1 - gl) * 640 + 512 + 4 * s + (q - 20);
                        bs1[(size_t)(gl * 128 + rr) * 1280 + col] = 0; }
                }
            } else if (item < I2) { const int it = item - I1, ntl = it / 16, kt = it % 16; tr_tile<0>(a.w_in, INW, 64 * kt, 384 + 64 * ntl, WIN, DM, sm, tid); }
            else if (item < I3) { const int it = item - I2, ntl = it / 16, kt = it % 16; tr_tile<0>(a.w_out, DM, 64 * kt, 64 * ntl, WOUT, DM, sm, tid); }
            else if (item < I4) { const int it = item - I3, ntl = it / 6, kt = it % 6; tr_tile<1>(a.w_glu, 768, 64 * kt, 64 * ntl, WGLU, 384, sm, tid); }
            else if (item < I5) { const int it = item - I4, ntl = it / 16, kt = it % 16; tr_tile<0>(a.w_kv, 512, 64 * kt, 64 * ntl, WKV, DM, sm, tid); }
            else {
                const int it = item - I5, kt = it >> 2, gi = it & 3, k0 = 64 * kt;
                LAS float* At = sm; LAS float* Wp = sm + 64 * 97;
                __syncthreads();
                for (int e = tid; e < 64 * 96; e += 512) { const int kk = e / 96, c = e % 96; At[kk * 97 + c] = a.w_in[(size_t)(k0 + kk) * INW + gi * 96 + c]; }
                for (int e = tid; e < 96 * 96; e += 512) Wp[e] = a.w_pool[(size_t)gi * 9216 + e];
                __syncthreads();
                const int kk = tid & 63, d0 = (tid >> 6) * 12;
                float ac[12];
#pragma unroll
                for (int i = 0; i < 12; ++i) ac[i] = 0.f;
                for (int c = 0; c < 96; ++c) { const float av = At[kk * 97 + c];
#pragma unroll
                    for (int i = 0; i < 12; ++i) ac[i] += av * Wp[c * 96 + d0 + i]; }
#pragma unroll
                for (int i = 0; i < 12; ++i) { const int d = gi * 96 + d0 + i; WIN[(size_t)d * DM + k0 + kk] = f2bf(ac[i] * a.pool_scale[d]); }
            }
        }
        rmsnorm_rows(a.mem, a.g_mem, MBF, NB * NMEM, bid * 8 + wave, G * 8, lane);
        rmsnorm_rows(a.x, a.g_pre, HB, NTOK, bid * 8 + wave, G * 8, lane);
    }
    SEAM(0); STAMP(1);

    if (IN(1)) REPS(1) {
        WSP;
        pg8::Gemm g{HB, WIN, DM, DM, 128, 128}; pg8::OrderStd S; S.init(NTOK, INW, DM, DM, G, bid, DM);
        pg8::EpiIn E{PROJ, UBUF};
        pg8::gemm_phase<pg8::EpiIn, pg8::OrderStd>(lds, g, S, E);
    }
    SEAM(1); STAMP(2);

    if (IN(2)) REPS(2) {
        WSP;
        { pg8::Gemm g{UBUF, BS1, 64, 1280, (size_t)UTILE * 2, 128}; pg8::OrderS1 S{G, bid}; pg8::EpiS1 E{SEND};
          pg8::gemm_phase<pg8::EpiS1, pg8::OrderS1>(lds, g, S, E); }
        STAMP(7);
        {
            TIDS;
            asm volatile("s_waitcnt vmcnt(0)" ::: "memory"); __syncthreads();
            for (int L = bid; L < 96; L += G) {
                const int pm = L / 12, p = L % 12, b = 4 * pm + (tid >> 7), g = 2 * p + ((tid >> 6) & 1), n = tid & 63;
                const float lr = LAMT[(g * SN + n) * 2], li = LAMT[(g * SN + n) * 2 + 1];
                float hr = 0.f, hi2 = 0.f;
                for (int k0 = 0; k0 < NCH; k0 += 16) {
                    float sr[16], si[16];
#pragma unroll
                    for (int k = 0; k < 16; ++k) { const size_t row = (size_t)b * NCH + k0 + k; sr[k] = SEND[row * 3072 + g * 128 + n]; si[k] = SEND[row * 3072 + g * 128 + 64 + n]; }
#pragma unroll
                    for (int k = 0; k < 16; ++k) {
                        const size_t row = (size_t)b * NCH + k0 + k;
                        { bf16_t* hp = UBUF + ((size_t)((g * 8 + (int)(row >> 8)) * 10 + 8) * 256 + (row & 255)) * 64 + n; hp[0] = f2bf(hr); hp[UTILE] = f2bf(hi2); }
                        const float nr = lr * hr - li * hi2 + sr[k], ni = lr * hi2 + li * hr + si[k]; hr = nr; hi2 = ni;
                    }
                }
            }
        }
        STAMP(8);
        { pg8::Gemm g{MBF, WKV, DM, DM, 128, 128}; pg8::OrderStd S; S.init(NB * NMEM, 512, DM, DM, G, (bid + 160) % G, DM); pg8::EpiKV E{KB, VT};
          pg8::gemm_phase<pg8::EpiKV, pg8::OrderStd>(lds, g, S, E); }
        { TIDS;
        { volatile LAS int* slot = (volatile LAS int*)(lds + 131072 + 16);
          for (;;) {
              __syncthreads();
              if (tid == 0) { const unsigned v = __hip_atomic_fetch_add(QW(0), 1u, __ATOMIC_RELAXED, __HIP_MEMORY_SCOPE_AGENT); *slot = (v < (unsigned)POOL_A) ? (int)v : -1; }
              __syncthreads();
              const int id = *slot;
              if (id < 0) break;
              pool_item(a.ws, id, tid);
          } }
        }
        STAMP(9);
    }
    SEAM(2); STAMP(3);

    if (IN(4)) REPS(4) {
        WSP;
        { pg8::Gemm g{UBUF, BS2, 64, 640, (size_t)UTILE * 2, 128}; pg8::OrderS2 S{G, bid}; pg8::EpiS2 E{YBUF};
          pg8::gemm_phase<pg8::EpiS2, pg8::OrderS2>(lds, g, S, E); }
        TIDS;
        { volatile LAS int* slot = (volatile LAS int*)(lds + 131072 + 16);
          for (;;) {
              __syncthreads();
              if (tid == 0) { const unsigned v = __hip_atomic_fetch_add(QW(1), 1u, __ATOMIC_RELAXED, __HIP_MEMORY_SCOPE_AGENT); *slot = (v < (unsigned)(256 - POOL_A)) ? (int)(POOL_A + v) : -1; }
              __syncthreads();
              const int id = *slot;
              if (id < 0) break;
              pool_item(a.ws, id, tid);
          } }
    }
    SEAM(4); STAMP(4);

    if (IN(5)) REPS(5) {
        WSP;
#ifndef NO_GLU
        { pg8::Gemm g{YBUF, WGLU, SSMW, SSMW, 128, 128}; pg8::OrderStd S; S.init(NTOK, 768, SSMW, SSMW, G, bid, SSMW); pg8::EpiGlu E{PROJ, GBUF};
          pg8::gemm_phase<pg8::EpiGlu, pg8::OrderStd>(lds, g, S, E); }
#endif
#ifndef NO_ATT
        TIDS;
        constexpr int VOFF = 256 * 160;
        const int fr = lane & 15, fq = lane >> 4;
        for (int item = bid; item < NB * 4 * NH; item += G) {
            const int b = item >> 4, rem = item & 15, h = rem & 3, qt = rem >> 2;
            const bf16_t* Kg = KB + (size_t)(b * NH + h) * NMEM * HD; const bf16_t* Vg = VT + (size_t)(b * NH + h) * NMEM * HD;
            const size_t tok0 = (size_t)b * SEQ + qt * 512 + wave * 16 + fr;
            bf16x8 qall[4][2]; u32x2 gall[4][4];
#pragma unroll
            for (int pass = 0; pass < 4; ++pass) {
#pragma unroll
                for (int kk = 0; kk < 2; ++kk) qall[pass][kk] = *(const bf16x8*)(PROJ + (tok0 + pass * 128) * INW + 768 + h * HD + 32 * kk + 8 * fq);
#pragma unroll
                for (int dt = 0; dt < 4; ++dt) gall[pass][dt] = *(const u32x2*)(PROJ + (tok0 + pass * 128) * INW + 1024 + 768 + h * HD + 16 * dt + 4 * fq);
            }
            __syncthreads();
            for (int e = tid; e < 2048; e += 512) { const int m = e >> 3, dc = e & 7; const u32x4 v = *(const u32x4*)(Kg + m * HD + dc * 8);
                const int slot = (m & ~31) + 16 * ((m >> 2) & 1) + 4 * ((m >> 3) & 3) + (m & 3);
                *(LAS u32x4*)(lds + slot * 160 + dc * 16) = v; }
            for (int e = tid; e < 2048; e += 512) { const int m = e >> 3, dc = e & 7; const u32x4 v = *(const u32x4*)(Vg + m * HD + dc * 8);
                LAS unsigned short* vp = (LAS unsigned short*)(lds + VOFF + (dc * 8) * 544 + m * 2);
                vp[0 * 272] = (unsigned short)(v.x & 0xffffu); vp[1 * 272] = (unsigned short)(v.x >> 16); vp[2 * 272] = (unsigned short)(v.y & 0xffffu); vp[3 * 272] = (unsigned short)(v.y >> 16);
                vp[4 * 272] = (unsigned short)(v.z & 0xffffu); vp[5 * 272] = (unsigned short)(v.z >> 16); vp[6 * 272] = (unsigned short)(v.w & 0xffffu); vp[7 * 272] = (unsigned short)(v.w >> 16); }
            __syncthreads();
#pragma unroll
            for (int pass = 0; pass < 4; ++pass) {
            const size_t token = tok0 + pass * 128;
            bf16x8 qf[2];
#pragma unroll
            for (int kk = 0; kk < 2; ++kk) qf[kk] = qall[pass][kk];
            f32x4 s[8][2];
            float mx = -3.0e38f;
#pragma unroll
            for (int blk = 0; blk < 8; ++blk)
#pragma unroll
                for (int sub = 0; sub < 2; ++sub) {
                    f32x4 ac = (f32x4){0.f, 0.f, 0.f, 0.f};
#pragma unroll
                    for (int kk = 0; kk < 2; ++kk) { const bf16x8 af = *(const LAS bf16x8*)(lds + (32 * blk + 16 * sub + fr) * 160 + (32 * kk + 8 * fq) * 2);
                        ac = __builtin_amdgcn_mfma_f32_16x16x32_bf16(af, qf[kk], ac, 0, 0, 0); }
                    s[blk][sub] = ac;
                    mx = fmaxf(mx, fmaxf(fmaxf(ac[0], ac[1]), fmaxf(ac[2], ac[3])));
                }
            mx = fmaxf(mx, __shfl_xor(mx, 16)); mx = fmaxf(mx, __shfl_xor(mx, 32));
            float sum = 0.f; bf16x8 pb[8];
#pragma unroll
            for (int blk = 0; blk < 8; ++blk) {
                f32x4 p0, p1;
#pragma unroll
                for (int j = 0; j < 4; ++j) { p0[j] = __builtin_amdgcn_exp2f(s[blk][0][j] - mx); p1[j] = __builtin_amdgcn_exp2f(s[blk][1][j] - mx); }
                sum += (p0[0] + p0[1]) + (p0[2] + p0[3]) + (p1[0] + p1[1]) + (p1[2] + p1[3]);
                const u32x4 pw = pg8::pack8(p0, p1); pb[blk] = __builtin_bit_cast(bf16x8, pw);
            }
            sum += __shfl_xor(sum, 16); sum += __shfl_xor(sum, 32);
            const float inv = 1.0f / sum;
#pragma unroll
            for (int dt = 0; dt < 4; ++dt) {
                f32x4 o = (f32x4){0.f, 0.f, 0.f, 0.f};
#pragma unroll
                for (int blk = 0; blk < 8; ++blk) { const bf16x8 vf = *(const LAS bf16x8*)(lds + VOFF + (16 * dt + fr) * 544 + (32 * blk + 8 * fq) * 2);
                    o = __builtin_amdgcn_mfma_f32_16x16x32_bf16(vf, pb[blk], o, 0, 0, 0); }
                const int d0 = 16 * dt + 4 * fq;
                const u32x2 sg = gall[pass][dt];
                u32x2 wv; wv.x = cvt_pk_bf16(o[0] * inv * bf_lo(sg.x), o[1] * inv * bf_hi(sg.x)); wv.y = cvt_pk_bf16(o[2] * inv * bf_lo(sg.y), o[3] * inv * bf_hi(sg.y));
                *(u32x2*)(GBUF + token * DM + 768 + h * HD + d0) = wv;
            }
            }
        }
#endif
    }
    SEAM(5); STAMP(5);

    if (IN(6)) REPS(6) {
        WSP;
        { pg8::Gemm g{GBUF, WOUT, DM, DM, 128, 128}; pg8::OrderPanel S{G, bid, DM / 64, (size_t)256 * DM * 2, (size_t)256 * DM * 2}; pg8::EpiOut E{OBUF, SSQ};
          pg8::gemm_phase<pg8::EpiOut, pg8::OrderPanel>(lds, g, S, E); }
        TIDS;
        asm volatile("s_waitcnt vmcnt(0)" ::: "memory"); __syncthreads();
        constexpr int BMR = 256;
        for (int panel = bid; panel < NTOK / BMR; panel += G)
        {
            const int nw = 8; int row = panel * BMR + 2 * wave; const int rend = panel * BMR + BMR;
            f32x4 gv[4];
#pragma unroll
            for (int i = 0; i < 4; ++i) gv[i] = *(const f32x4*)(a.g_post + 4 * (lane + 64 * i));
            if (row < rend) {
                float sq0 = (lane < 16) ? SSQ[(size_t)row * 16 + lane] : 0.f, sq1 = (lane < 16) ? SSQ[(size_t)(row + 1) * 16 + lane] : 0.f;
                u32x2 o0[4], o1[4]; f32x4 x0[4], x1[4];
#pragma unroll
                for (int i = 0; i < 4; ++i) { const int c = 4 * (lane + 64 * i);
                    o0[i] = *(const u32x2*)(OBUF + (size_t)row * DM + c); o1[i] = *(const u32x2*)(OBUF + (size_t)(row + 1) * DM + c);
                    x0[i] = __builtin_nontemporal_load((const f32x4*)(a.x + (size_t)row * DM + c)); x1[i] = __builtin_nontemporal_load((const f32x4*)(a.x + (size_t)(row + 1) * DM + c)); }
                for (;;) {
                    const int nrow = row + 2 * nw; const bool more = nrow < rend;
                    float nq0 = 0.f, nq1 = 0.f; u32x2 p0[4], p1[4]; f32x4 y0[4], y1[4];
                    if (more) {
                        nq0 = (lane < 16) ? SSQ[(size_t)nrow * 16 + lane] : 0.f; nq1 = (lane < 16) ? SSQ[(size_t)(nrow + 1) * 16 + lane] : 0.f;
#pragma unroll
                        for (int i = 0; i < 4; ++i) { const int c = 4 * (lane + 64 * i);
                            p0[i] = *(const u32x2*)(OBUF + (size_t)nrow * DM + c); p1[i] = *(const u32x2*)(OBUF + (size_t)(nrow + 1) * DM + c);
                            y0[i] = __builtin_nontemporal_load((const f32x4*)(a.x + (size_t)nrow * DM + c)); y1[i] = __builtin_nontemporal_load((const f32x4*)(a.x + (size_t)(nrow + 1) * DM + c)); }
                    }
                    const float rs0 = rsqrtf(wave_sum(sq0) * (1.0f / DM) + EPS), rs1 = rsqrtf(wave_sum(sq1) * (1.0f / DM) + EPS);
#pragma unroll
                    for (int i = 0; i < 4; ++i) { const int c = 4 * (lane + 64 * i);
                        f32x4 r;
                        r[0] = x0[i][0] + bf_lo(o0[i].x) * rs0 * gv[i][0]; r[1] = x0[i][1] + bf_hi(o0[i].x) * rs0 * gv[i][1]; r[2] = x0[i][2] + bf_lo(o0[i].y) * rs0 * gv[i][2]; r[3] = x0[i][3] + bf_hi(o0[i].y) * rs0 * gv[i][3];
                        __builtin_nontemporal_store(r, (f32x4*)(a.out + (size_t)row * DM + c));
                        r[0] = x1[i][0] + bf_lo(o1[i].x) * rs1 * gv[i][0]; r[1] = x1[i][1] + bf_hi(o1[i].x) * rs1 * gv[i][1]; r[2] = x1[i][2] + bf_lo(o1[i].y) * rs1 * gv[i][2]; r[3] = x1[i][3] + bf_hi(o1[i].y) * rs1 * gv[i][3];
                        __builtin_nontemporal_store(r, (f32x4*)(a.out + (size_t)(row + 1) * DM + c)); }
                    if (!more) break;
                    sq0 = nq0; sq1 = nq1;
#pragma unroll
                    for (int i = 0; i < 4; ++i) { o0[i] = p0[i]; o1[i] = p1[i]; x0[i] = y0[i]; x1[i] = y1[i]; }
                    row = nrow;
                }
            }
        }
    }
#ifdef PROBE_TS
    STAMP(6);
    if (blockIdx.x == 0 && threadIdx.x == 0) {
        volatile LAS unsigned long long* tsp = (volatile LAS unsigned long long*)(lds + 131072 + 64);
#ifndef PROBE_TS_TO
#define PROBE_TS_TO (PROBE_TS + 1)
#endif
#ifndef PROBE_MUL
#define PROBE_MUL 1
#endif
        const unsigned long long d = PROBE_MUL * (tsp[PROBE_TS_TO] - tsp[PROBE_TS]), t0 = __builtin_amdgcn_s_memrealtime();
        while (__builtin_amdgcn_s_memrealtime() - t0 < d) __builtin_amdgcn_s_sleep(8);
    }
#endif
#undef IN
#undef SEAM
}

extern "C" void kernel_launch(void* const* d_in, const int* in_sizes, int n_in, void* d_out, int out_size, void* d_ws, size_t ws_size, hipStream_t stream) {
    static int grid = 0;
    if (grid == 0) {
        if (n_in != 19 || ws_size < WS_END) { fprintf(stderr, "kernel_launch: unexpected inputs (n_in %d, ws %zu < %zu)\n", n_in, ws_size, (size_t)WS_END); grid = -1; return; }
        int dev = 0, cus = 0, per_cu = 0;
        hipGetDevice(&dev); hipDeviceGetAttribute(&cus, hipDeviceAttributeMultiprocessorCount, dev);
        if (hipFuncSetAttribute((const void*)mega, hipFuncAttributeMaxDynamicSharedMemorySize, LDS_BYTES) != hipSuccess) { fprintf(stderr, "kernel_launch: hipFuncSetAttribute failed\n"); grid = -1; return; }
        if (hipOccupancyMaxActiveBlocksPerMultiprocessor(&per_cu, (const void*)mega, 512, LDS_BYTES) != hipSuccess || per_cu < 1) { fprintf(stderr, "kernel_launch: occupancy query says %d\n", per_cu); per_cu = 1; }
        (void)hipGetLastError();
        grid = cus;
    }
    if (grid < 0) return;
    Args a{};
    a.x = (const float*)d_in[0]; a.mem = (const float*)d_in[1]; a.g_pre = (const float*)d_in[2]; a.w_in = (const float*)d_in[3]; a.w_pool = (const float*)d_in[4];
    a.pool_scale = (const float*)d_in[5]; a.a_re = (const float*)d_in[6]; a.a_im = (const float*)d_in[7]; a.log_dt = (const float*)d_in[8]; a.b_re = (const float*)d_in[9];
    a.b_im = (const float*)d_in[10]; a.c_re = (const float*)d_in[11]; a.c_im = (const float*)d_in[12]; a.d_skip = (const float*)d_in[13]; a.w_glu = (const float*)d_in[14];
    a.g_mem = (const float*)d_in[15]; a.w_kv = (const float*)d_in[16]; a.w_out = (const float*)d_in[17]; a.g_post = (const float*)d_in[18];
    a.out = (float*)d_out; a.ws = (unsigned char*)d_ws;
    (void)hipMemsetAsync((char*)d_ws + WS_CTL, 0, CTL_BYTES, stream);
#if ONE_LAUNCH
    a.ph_lo = 0; a.ph_hi = 8;
    void* args[] = {&a};
    hipError_t e = hipLaunchCooperativeKernel((const void*)mega, dim3(grid), dim3(512), args, LDS_BYTES, stream);
    if (e != hipSuccess) fprintf(stderr, "kernel_launch: cooperative launch failed: %s (grid %d)\n", hipGetErrorString(e), grid);
#else
    for (int p = 0; p < 8; ++p) { a.ph_lo = p; a.ph_hi = p + 1; hipLaunchKernelGGL(mega, dim3(grid), dim3(512), LDS_BYTES, stream, a); }
#endif
}
```
